# Optimizing an MI355X kernel written in HIP

```python
import math
import jax, jax.numpy as jnp
from jax import lax
import numpy as np

D_MODEL = 2048
BATCH = 4
SEQ = 2048
DEPTH = 1

CHUNK = 64
MIX_WIDTH = D_MODEL
RET_WIDTH = MIX_WIDTH // 2
ATT_WIDTH = MIX_WIDTH - RET_WIDTH
RET_HEAD_DIM = 256
RET_HEADS = RET_WIDTH // RET_HEAD_DIM
ATT_HEAD_DIM = 128
ATT_HEADS = ATT_WIDTH // ATT_HEAD_DIM
LEFT_CHUNKS = 8
BAND_CHUNKS = LEFT_CHUNKS + 1
MAX_REL = 256
REL_SIZE = MAX_REL + CHUNK
ROPE_BASE = 10000.0
N_EXPERTS = 32
TOP_K = 4
D_FF = D_MODEL
SWIGLU_LIMIT = 7.0
SWIGLU_ALPHA = 1.702
EXPERT_BLOCK = 256
NORM_EPS = 1e-6
IN_COLS = 4 * RET_WIDTH + 3 * ATT_WIDTH
NEG_INF = -1e30

kernel_name = 'hybrid_retention_chunkattn_moe_block'


def rms_norm(x, gain):
    x32 = x.astype(jnp.float32)
    y = x32 * lax.rsqrt(jnp.mean(x32 * x32, axis=-1, keepdims=True) + NORM_EPS)
    return (y * gain.astype(jnp.float32)).astype(x.dtype)


def rotary(t, positions):
    half = t.shape[-1] // 2
    inv_freq = 1.0 / (ROPE_BASE ** (jnp.arange(half, dtype=jnp.float32) / half))
    ang = positions.astype(jnp.float32)[..., None] * inv_freq
    cos = jnp.cos(ang)[:, :, None, :].astype(t.dtype)
    sin = jnp.sin(ang)[:, :, None, :].astype(t.dtype)
    t1, t2 = t[..., :half], t[..., half:]
    return jnp.concatenate([t1 * cos - t2 * sin, t1 * sin + t2 * cos], axis=-1)


def retention(q, k, v, g, positions):
    B, S, _ = q.shape
    L = CHUNK
    NC = S // L
    dt = q.dtype
    q = rotary(q.reshape(B, S, RET_HEADS, RET_HEAD_DIM), positions)
    k = rotary(k.reshape(B, S, RET_HEADS, RET_HEAD_DIM), positions) * (RET_HEAD_DIM ** -0.5)
    v = v.reshape(B, S, RET_HEADS, RET_HEAD_DIM)
    log_gamma = jnp.log(1.0 - jnp.exp(jnp.linspace(math.log(1.0 / 32), math.log(1.0 / 512), RET_HEADS)))
    n = jnp.arange(L, dtype=jnp.float32)
    d_intra = jnp.exp(jnp.abs(n[:, None] - n[None, :])[None] * log_gamma[:, None, None]).astype(dt)
    d_q = jnp.exp((n[:, None] + 1.0) * log_gamma[None, :]).astype(dt)
    d_k = jnp.exp((L - 1.0 - n)[:, None] * log_gamma[None, :]).astype(dt)
    d_chunk = jnp.exp(L * log_gamma).astype(dt)
    qc = q.reshape(B, NC, L, RET_HEADS, RET_HEAD_DIM)
    kc = k.reshape(B, NC, L, RET_HEADS, RET_HEAD_DIM)
    vc = v.reshape(B, NC, L, RET_HEADS, RET_HEAD_DIM)
    s = jnp.einsum('bcnhd,bcmhd->bchnm', qc, kc) * d_intra[None, None]
    o = jnp.einsum('bchnm,bcmhe->bcnhe', s, vc)
    kv = jnp.einsum('bcmhd,bcmhe->bchde', kc * d_k[None, None, :, :, None], vc)

    def step(state, kv_c):
        return state * d_chunk[None, :, None, None] + kv_c, state

    _, s_prev = lax.scan(step, jnp.zeros_like(kv[:, 0]), jnp.moveaxis(kv, 1, 0))
    s_prev = jnp.moveaxis(s_prev, 0, 1)
    o = o + jnp.einsum('bcnhd,bchde->bcnhe', qc * d_q[None, None, :, :, None], s_prev)
    o32 = o.astype(jnp.float32)
    o32 = o32 * lax.rsqrt(jnp.mean(o32 * o32, axis=-1, keepdims=True) + NORM_EPS)
    return o32.reshape(B, S, RET_WIDTH).astype(dt) * jax.nn.silu(g)


def chunked_attention(q, k, v, rel_bias):
    B, S, _ = q.shape
    L = CHUNK
    NC = S // L
    q = q.reshape(B, NC, L, ATT_HEADS, ATT_HEAD_DIM)
    pad = ((0, 0), (LEFT_CHUNKS * L, 0), (0, 0))
    kc = jnp.pad(k, pad).reshape(B, NC + LEFT_CHUNKS, L, ATT_HEADS, ATT_HEAD_DIM)
    vc = jnp.pad(v, pad).reshape(B, NC + LEFT_CHUNKS, L, ATT_HEADS, ATT_HEAD_DIM)
    band = jnp.arange(NC)[:, None] + jnp.arange(BAND_CHUNKS)[None, :]
    kb = kc[:, band].reshape(B, NC, BAND_CHUNKS * L, ATT_HEADS, ATT_HEAD_DIM)
    vb = vc[:, band].reshape(B, NC, BAND_CHUNKS * L, ATT_HEADS, ATT_HEAD_DIM)
    valid = jnp.repeat(band >= LEFT_CHUNKS, L, axis=1)
    n = jnp.arange(L)
    w = jnp.arange(BAND_CHUNKS)
    rel = (LEFT_CHUNKS - w)[None, :, None] * L + n[:, None, None] - n[None, None, :]
    idx = jnp.clip(rel, -(L - 1), MAX_REL) + (L - 1)
    bias = rel_bias[:, idx.reshape(L, BAND_CHUNKS * L)].astype(jnp.float32)
    s = jnp.einsum('bcnhd,bckhd->bhcnk', q, kb).astype(jnp.float32) * (ATT_HEAD_DIM ** -0.5) + bias[None, :, None]
    s = jnp.where(valid[None, None, :, None, :], s, NEG_INF)
    p = jax.nn.softmax(s, axis=-1).astype(v.dtype)
    o = jnp.einsum('bhcnk,bckhd->bcnhd', p, vb)
    return o.reshape(B, S, ATT_WIDTH)


def moe(xn, router_w, router_b, w_gate, b_gate, w_up, b_up, w_down, b_down):
    T, D = xn.shape
    logits = (xn @ router_w + router_b).astype(jnp.float32)
    top_v, top_i = lax.top_k(logits, TOP_K)
    gates = jax.nn.softmax(top_v, axis=-1)
    A = T * TOP_K
    e = top_i.reshape(A)
    tok = jnp.repeat(jnp.arange(T, dtype=jnp.int32), TOP_K)
    wts = gates.reshape(A)
    order = jnp.argsort(e)
    se, stok, sw = e[order], tok[order], wts[order]
    counts = jnp.zeros((N_EXPERTS,), jnp.int32).at[e].add(1)
    starts = jnp.cumsum(counts) - counts
    padded = ((counts + EXPERT_BLOCK - 1) // EXPERT_BLOCK) * EXPERT_BLOCK
    pends = jnp.cumsum(padded)
    pstarts = pends - padded
    dest = pstarts[se] + jnp.arange(A, dtype=jnp.int32) - starts[se]
    NB = A // EXPERT_BLOCK + N_EXPERTS
    P = NB * EXPERT_BLOCK
    buf_tok = jnp.full((P,), T, jnp.int32).at[dest].set(stok)
    buf_w = jnp.zeros((P,), jnp.float32).at[dest].set(sw)
    blk_e = jnp.minimum(jnp.searchsorted(pends, jnp.arange(NB, dtype=jnp.int32) * EXPERT_BLOCK, side='right'), N_EXPERTS - 1)
    x_pad = jnp.concatenate([xn, jnp.zeros((1, D), xn.dtype)], axis=0)

    def expert_block(args):
        tok_b, w_b, e_b = args
        xb = x_pad[tok_b]
        gate = jnp.minimum(xb @ w_gate[e_b] + b_gate[e_b], SWIGLU_LIMIT)
        up = jnp.clip(xb @ w_up[e_b] + b_up[e_b], -SWIGLU_LIMIT, SWIGLU_LIMIT)
        hid = (up + 1.0) * gate * jax.nn.sigmoid(SWIGLU_ALPHA * gate)
        return (hid @ w_down[e_b] + b_down[e_b]) * w_b[:, None]

    outs = lax.map(expert_block, (buf_tok.reshape(NB, EXPERT_BLOCK), buf_w.reshape(NB, EXPERT_BLOCK).astype(xn.dtype), blk_e))
    y = jnp.zeros((T + 1, D), xn.dtype).at[buf_tok].add(outs.reshape(P, D))
    return y[:T]


def setup_inputs(seed: int = 0) -> dict:
    key = jax.random.key(seed)
    ks = jax.random.split(key, 18)
    f32 = jnp.float32
    x = jax.random.normal(ks[0], (BATCH, SEQ, D_MODEL), f32)
    start = jax.random.randint(ks[1], (BATCH, 1), 0, 100000, dtype=jnp.int32)
    positions = (start + jnp.arange(SEQ, dtype=jnp.int32)[None, :]).astype(jnp.int32)
    norm_mix_g = 1.0 + 0.02 * jax.random.normal(ks[2], (DEPTH, D_MODEL), f32)
    w_in = jax.random.normal(ks[3], (DEPTH, D_MODEL, IN_COLS), f32) * D_MODEL ** -0.5
    w_out = jax.random.normal(ks[4], (DEPTH, MIX_WIDTH, D_MODEL), f32) * MIX_WIDTH ** -0.5
    rel_bias = 0.1 * jax.random.normal(ks[5], (DEPTH, ATT_HEADS, REL_SIZE), f32)
    norm_ffn_g = 1.0 + 0.02 * jax.random.normal(ks[6], (DEPTH, D_MODEL), f32)
    router_w = jax.random.normal(ks[7], (DEPTH, D_MODEL, N_EXPERTS), f32) * D_MODEL ** -0.5
    router_b = 0.01 * jax.random.normal(ks[8], (DEPTH, N_EXPERTS), f32)
    w_gate = jax.random.normal(ks[9], (DEPTH, N_EXPERTS, D_MODEL, D_FF), f32) * D_MODEL ** -0.5
    b_gate = 0.01 * jax.random.normal(ks[10], (DEPTH, N_EXPERTS, D_FF), f32)
    w_up = jax.random.normal(ks[11], (DEPTH, N_EXPERTS, D_MODEL, D_FF), f32) * D_MODEL ** -0.5
    b_up = 0.01 * jax.random.normal(ks[12], (DEPTH, N_EXPERTS, D_FF), f32)
    w_down = jax.random.normal(ks[13], (DEPTH, N_EXPERTS, D_FF, D_MODEL), f32) * D_FF ** -0.5
    b_down = 0.01 * jax.random.normal(ks[14], (DEPTH, N_EXPERTS, D_MODEL), f32)
    norm_final_g = 1.0 + 0.02 * jax.random.normal(ks[15], (D_MODEL,), f32)
    return {'x': x, 'positions': positions, 'norm_mix_g': norm_mix_g, 'w_in': w_in, 'w_out': w_out,
            'rel_bias': rel_bias, 'norm_ffn_g': norm_ffn_g, 'router_w': router_w, 'router_b': router_b,
            'w_gate': w_gate, 'b_gate': b_gate, 'w_up': w_up, 'b_up': b_up, 'w_down': w_down,
            'b_down': b_down, 'norm_final_g': norm_final_g}


def reference(x, positions, norm_mix_g, w_in, w_out, rel_bias, norm_ffn_g, router_w, router_b,
              w_gate, b_gate, w_up, b_up, w_down, b_down, norm_final_g):
    B, S, D = x.shape
    splits = [RET_WIDTH, 2 * RET_WIDTH, 3 * RET_WIDTH, 4 * RET_WIDTH,
              4 * RET_WIDTH + ATT_WIDTH, 4 * RET_WIDTH + 2 * ATT_WIDTH]
    h = x
    for l in range(DEPTH):
        hn = rms_norm(h, norm_mix_g[l])
        proj = hn @ w_in[l]
        rq, rk, rv, rg, aq, ak, av = jnp.split(proj, splits, axis=-1)
        ret = retention(rq, rk, rv, rg, positions)
        att = chunked_attention(aq, ak, av, rel_bias[l])
        h = h + jnp.concatenate([ret, att], axis=-1) @ w_out[l]
        hn = rms_norm(h, norm_ffn_g[l])
        y = moe(hn.reshape(B * S, D), router_w[l], router_b[l], w_gate[l], b_gate[l],
                w_up[l], b_up[l], w_down[l], b_down[l])
        h = h + y.reshape(B, S, D)
    return rms_norm(h, norm_final_g)
```

```cpp
#include <hip/hip_runtime.h>
#include <cstdio>
#include <cstdint>

namespace {
#define GAS __attribute__((address_space(1)))
#define LAS __attribute__((address_space(3)))
typedef unsigned short bf16_t;
typedef short bf16x8 __attribute__((ext_vector_type(8)));
typedef short s16x4 __attribute__((ext_vector_type(4)));
typedef float f32x4 __attribute__((ext_vector_type(4)));
typedef float f32x16 __attribute__((ext_vector_type(16)));
typedef unsigned u32x4 __attribute__((ext_vector_type(4)));
typedef unsigned u32x2 __attribute__((ext_vector_type(2)));

constexpr int NTOK = 8192, DM = 2048, SEQ = 2048, NBATCH = 4, NCH = 32, CH = 64;
constexpr int INC = 7168;
constexpr int OFF_RQ = 0, OFF_RK = 1024, OFF_RV = 2048, OFF_RG = 3072, OFF_AQ = 4096, OFF_AK = 5120, OFF_AV = 6144;
constexpr int NEXP = 32, TOPK = 4, MAXMT = 160, MAXSLOT = MAXMT * 256;
constexpr float NORM_EPS = 1e-6f;
constexpr int NPHASE = 9;
constexpr int KD = 2048;

constexpr size_t MiB = 1u << 20;
constexpr size_t WS_CTL = 0, CTL_ZERO_BYTES = 1 * MiB;
constexpr size_t WS_XN = 1 * MiB;
constexpr size_t WS_WIN = 33 * MiB;
constexpr size_t WS_WOUT = 61 * MiB;
constexpr size_t WS_WG = 69 * MiB;
constexpr size_t WS_WU = 325 * MiB;
constexpr size_t WS_WD = 581 * MiB;
constexpr size_t WS_COS = 837 * MiB;
constexpr size_t WS_SIN = 841 * MiB;
constexpr size_t WS_PROJ = 845 * MiB;
constexpr size_t WS_MIX = 957 * MiB;
constexpr size_t WS_H1 = 989 * MiB;
constexpr size_t WS_RT = 1053 * MiB;
constexpr size_t WS_XG = 1055 * MiB;
constexpr size_t WS_HID = 1215 * MiB;
constexpr size_t WS_YB = 1375 * MiB;
constexpr size_t WS_END = 1535 * MiB;
constexpr size_t RT_TOPE = 0, RT_TOPW = 128 * 1024, RT_RSTD = 256 * 1024, RT_LRANK = 384 * 1024, RT_HIST = 512 * 1024, RT_TOKPOS = 640 * 1024, RT_SLOTW = 768 * 1024;
constexpr int CW_TMO = 0, CW_BAR = 4096, CW_WQ = 8192, CW_NMT = 8256, CW_MTE = 8320;

constexpr int RING_OFF = 0, RING_BYTES = 131072;
constexpr int TAB_OFF = 147456;
constexpr int CTL_OFF = 151552;
constexpr int LDS_BYTES = 152576;

#define LDS_WAIT() asm volatile("s_waitcnt lgkmcnt(0)" ::: "memory")
#define VM_WAIT() asm volatile("s_waitcnt vmcnt(0)" ::: "memory")
#define RLX_AGENT __ATOMIC_RELAXED, __HIP_MEMORY_SCOPE_AGENT

__device__ __forceinline__ unsigned cvt_pk_bf16(float lo, float hi) { unsigned r; asm volatile("v_cvt_pk_bf16_f32 %0, %1, %2" : "=v"(r) : "v"(lo), "v"(hi)); return r; }
__device__ __forceinline__ float bf_lo(unsigned u) { return __builtin_bit_cast(float, u << 16); }
__device__ __forceinline__ float bf_hi(unsigned u) { return __builtin_bit_cast(float, u & 0xffff0000u); }
__device__ __forceinline__ float wave_sum(float v) {
#pragma unroll
    for (int o = 1; o < 64; o <<= 1) v += __shfl_xor(v, o);
    return v;
}
__device__ __forceinline__ unsigned ld_u32_agent(const unsigned* p) { return __hip_atomic_load(p, RLX_AGENT); }

#define XB_TMO      128
#define XB_XCNT(j)  (256  + 64 * (j))
#define XB_XSUB(j)  (1280 + 64 * (j))
#define XB_XGEN(j)  (2304 + 64 * (j))
#define XB_TOP      3328
#define XB_TOPGEN   3392
#define XCD_BAR_WORDS 3456
#define XB_SPIN_CAP (1u << 18)
__device__ __forceinline__ unsigned xb_ld(unsigned* p)              { return __hip_atomic_load(p, __ATOMIC_RELAXED, __HIP_MEMORY_SCOPE_AGENT); }
__device__ __forceinline__ unsigned xb_add(unsigned* p, unsigned v) { return __hip_atomic_fetch_add(p, v, __ATOMIC_RELAXED, __HIP_MEMORY_SCOPE_AGENT); }
__device__ __forceinline__ unsigned xb_xcc_id() { return (unsigned)__builtin_amdgcn_s_getreg((3 << 11) | 20) & 0xFu; }
#define XB_SPIN(cond, bar) do { unsigned _sp = 0; while (cond) { __builtin_amdgcn_s_sleep(1); \
    if ((++_sp & 255u) == 0u) { if (xb_ld(&(bar)[XB_TMO])) break; if (_sp > XB_SPIN_CAP) { atomicAdd(&(bar)[XB_TMO], 1u); break; } } } } while (0)
struct XcdBarrier { unsigned* bar; unsigned x; volatile LAS unsigned* st; };
__device__ __forceinline__ XcdBarrier xcd_barrier_post(unsigned* bar, volatile LAS unsigned* st) {
    XcdBarrier b; b.bar = bar; b.x = xb_xcc_id(); b.st = st;
    if (threadIdx.x == 0) (void)xb_add(&bar[XB_XCNT(b.x)], 1u);
    return b;
}
__device__ __forceinline__ void xcd_barrier_complete(unsigned* bar, unsigned x, unsigned& nloc, unsigned& nx) {
    const unsigned G = gridDim.x * gridDim.y * gridDim.z;
    unsigned sum, cnt, mine, sp = 0u;
    for (;;) {
        sum = 0u; cnt = 0u; mine = 0u;
#pragma unroll
        for (unsigned j = 0; j < 16; ++j) { const unsigned c = xb_ld(&bar[XB_XCNT(j)]); sum += c; cnt += (c > 0u) ? 1u : 0u; mine = (j == x) ? c : mine; }
        if (sum == G) break;
        __builtin_amdgcn_s_sleep(1);
        if ((++sp & 255u) == 0u) { if (xb_ld(&bar[XB_TMO])) break; if (sp > XB_SPIN_CAP) { atomicAdd(&bar[XB_TMO], 1u); break; } }
    }
    nloc = mine > 0u ? mine : 1u; nx = cnt > 0u ? cnt : 1u;
}
__device__ __forceinline__ void xcd_barrier(const XcdBarrier& b) {
    asm volatile("s_waitcnt vmcnt(0)" ::: "memory");
    __syncthreads();
    if (threadIdx.x == 0) {
        unsigned* bar = b.bar;
        __builtin_amdgcn_s_waitcnt(0);
        unsigned nloc = b.st[0], nx = b.st[1];
        if (nloc == 0u) { xcd_barrier_complete(bar, b.x, nloc, nx); b.st[0] = nloc; b.st[1] = nx; }
        const unsigned old = xb_add(&bar[XB_XSUB(b.x)], 1u);
        const unsigned gen = old / nloc;
        if (old + 1u == (gen + 1u) * nloc) {
            __builtin_amdgcn_fence(__ATOMIC_RELEASE, "agent");
            asm volatile("s_waitcnt vmcnt(0)" ::: "memory");
            const unsigned og = xb_add(&bar[XB_TOP], 1u);
            const unsigned tg = og / nx;
            if (og + 1u == (tg + 1u) * nx) xb_add(&bar[XB_TOPGEN], 1u);
            else XB_SPIN(xb_ld(&bar[XB_TOPGEN]) == tg, bar);
            __builtin_amdgcn_fence(__ATOMIC_ACQUIRE, "agent");
            xb_add(&bar[XB_XGEN(b.x)], 1u);
            asm volatile("s_waitcnt vmcnt(0)" ::: "memory");
        } else {
            XB_SPIN(xb_ld(&bar[XB_XGEN(b.x)]) == gen, bar);
            __builtin_amdgcn_fence(__ATOMIC_ACQUIRE, "agent");
            asm volatile("s_waitcnt vmcnt(0)" ::: "memory");
        }
    }
    __syncthreads();
}

constexpr int BM = 256, BK = 64, HALF = 128, HTB = HALF * BK * 2, NXCD = 8, WGM = 8;
__device__ __forceinline__ int lds_byte(int r, int c) { const int st = (r >> 4) * 2 + (c >> 5), rr = r & 15, cc = c & 31, ob = rr * 64 + cc * 2; return st * 1024 + (ob ^ (((ob >> 9) & 1) << 5)); }
__device__ __forceinline__ void stage_rc(int b, int& R, int& C) { const int st = b / 1024, sb = b % 1024, swz = sb ^ (((sb >> 9) & 1) << 5); R = (st >> 1) * 16 + swz / 64; C = (st & 1) * 32 + (swz % 64) / 2; }
__device__ __forceinline__ int perm32(int rho) { const int n = rho >> 4, i = rho & 15; return 8 * (i >> 2) + 4 * n + (i & 3); }

struct Unit { const char* a; const char* b; int pm, pn, e; };

struct DenseOrder {
    const char* A; const char* B; int nM, nN, nwg, G, c;
    __device__ void init(const void* A_, const void* B_, int M, int N, int G_, int c_) { A = (const char*)A_; B = (const char*)B_; nM = M / BM; nN = N / BM; nwg = nM * nN; G = G_; c = c_; }
    __device__ __forceinline__ bool next(int i, Unit& u) const {
        const long L = (long)i * G + c; if (L >= nwg) return false;
        int wgid = (int)L; { const int q = nwg / NXCD, r = nwg % NXCD, xcd = wgid % NXCD, off = wgid / NXCD; wgid = (xcd < r ? xcd * (q + 1) : r * (q + 1) + (xcd - r) * q) + off; }
        const int nig = WGM * nN, gid = wgid / nig, fm = gid * WGM, gsz = (nM - fm) < WGM ? (nM - fm) : WGM;
        u.pm = fm + ((wgid % nig) % gsz); u.pn = (wgid % nig) / gsz; u.e = 0;
        u.a = A + (size_t)u.pm * (size_t)(BM * KD * 2); u.b = B + (size_t)u.pn * (size_t)(BM * KD * 2); return true;
    }
};
template <int NT, int BROWS  > struct MoeOrder {
    const char* A; const char* B; const LAS int* mte; int nmt, G, c;
    __device__ __forceinline__ bool next(int i, Unit& u) const {
        const int L = i * G + c; if (L >= nmt * NT) return false;
        const int mt = L / NT, nt = L % NT;
        const int e = __builtin_amdgcn_readfirstlane(mte[mt]);
        u.pm = mt; u.pn = nt; u.e = e;
        u.a = A + (size_t)mt * (size_t)(BM * KD * 2); u.b = B + ((size_t)e * 2048 + (size_t)nt * BROWS) * (size_t)(KD * 2); return true;
    }
};

template <class Epi, class Sched>
__device__ __forceinline__ void gemm_phase(LAS unsigned char* lds, const Sched& S, const Epi& E, const size_t bhstep) {
    const int tid = threadIdx.x, wid = __builtin_amdgcn_readfirstlane(tid >> 6), lane = tid & 63, wr = wid >> 2, wc = wid & 3, fr = lane & 15, fq = lane >> 4;
    constexpr int K = KD, nt = K / BK;
    unsigned voffA[2], voffB[2];
#pragma unroll
    for (int i = 0; i < 2; ++i) { int R, C; stage_rc(tid * 16 + i * 8192, R, C); const int Rb = Epi::PERM ? ((R & ~31) + perm32(R & 31)) : R;
        voffA[i] = (unsigned)(R * K + C) * 2u; voffB[i] = (unsigned)(Rb * K + C) * 2u; }
    const size_t kstep = (size_t)(BK * 2);
    const size_t hstep = (size_t)HALF * K * 2;
    const unsigned ldsw = (unsigned)wid * 1024u;
    const int aoff = lds_byte(wr * 64 + fr, fq * 8), boff = lds_byte(wc * 32 + fr, fq * 8);
#define PG8_SA(b, h) (((b) * 2 + (h)) * HTB)
#define PG8_SB(b, h) ((4 + (b) * 2 + (h)) * HTB)
#define PG8_STAGE(bufoff, gbase, voff) do { _Pragma("unroll") for (int _i = 0; _i < 2; ++_i) \
        __builtin_amdgcn_global_load_lds((const unsigned*)((const char*)(gbase) + (voff)[_i]), (LAS unsigned*)(lds + (bufoff) + ldsw + _i * 8192), 16, 0, 0); } while (0)
#define PG8_LDA(dst, b, h) do { _Pragma("unroll") for (int m = 0; m < 4; ++m) _Pragma("unroll") for (int k = 0; k < 2; ++k) dst[m][k] = *(const LAS bf16x8*)(lds + PG8_SA(b, h) + aoff + m * 2048 + k * 1024); } while (0)
#define PG8_LDB(dst, b, h) do { _Pragma("unroll") for (int n = 0; n < 2; ++n) _Pragma("unroll") for (int k = 0; k < 2; ++k) dst[n][k] = *(const LAS bf16x8*)(lds + PG8_SB(b, h) + boff + n * 2048 + k * 1024); } while (0)
#define PG8_MMA(ai, bj, At, Bt) do { __builtin_amdgcn_s_setprio(1); _Pragma("unroll") for (int m = 0; m < 4; ++m) _Pragma("unroll") for (int n = 0; n < 2; ++n) _Pragma("unroll") for (int k = 0; k < 2; ++k) \
        acc[ai][bj][m][n] = __builtin_amdgcn_mfma_f32_16x16x32_bf16(Bt[n][k], At[m][k], acc[ai][bj][m][n], 0, 0, 0); __builtin_amdgcn_s_setprio(0); } while (0)
#define PG8_WAIT_V(n) asm volatile("s_waitcnt vmcnt(" #n ")" ::: "memory")
#define PG8_WAIT_L(n) asm volatile("s_waitcnt lgkmcnt(" #n ")" ::: "memory")
#define PG8_BAR __builtin_amdgcn_s_barrier()
#define PG8_SCHED __builtin_amdgcn_sched_barrier(0)
    Unit cur, nxt; int ui = 0;
    if (!S.next(0, cur)) return;
    f32x4 acc[2][2][4][2];
#pragma unroll
    for (int a = 0; a < 2; ++a)
#pragma unroll
        for (int b = 0; b < 2; ++b)
#pragma unroll
            for (int m = 0; m < 4; ++m)
#pragma unroll
                for (int n = 0; n < 2; ++n) acc[a][b][m][n] = (f32x4){0.f, 0.f, 0.f, 0.f};
    bf16x8 At[4][2], B0[2][2], B1[2][2];
    const char* cA = cur.a; const char* cB = cur.b;
    PG8_STAGE(PG8_SB(0, 0), cB, voffB); PG8_STAGE(PG8_SB(0, 1), cB + bhstep, voffB); PG8_STAGE(PG8_SA(0, 0), cA, voffA); PG8_STAGE(PG8_SA(0, 1), cA + hstep, voffA);
    if (wr == 1) PG8_BAR;
    PG8_WAIT_V(2); PG8_BAR;
    PG8_STAGE(PG8_SB(1, 0), cB + kstep, voffB); PG8_STAGE(PG8_SA(1, 0), cA + kstep, voffA); PG8_STAGE(PG8_SB(1, 1), cB + bhstep + kstep, voffB);
    PG8_WAIT_V(6); PG8_BAR;
    for (;;) {
        const bool has_next = S.next(ui + 1, nxt);
        const char* nA = has_next ? nxt.a : cA; const char* nB = has_next ? nxt.b : cB;
        for (int t = 0; t < nt; t += 2) {
            const bool last = (t == nt - 2);
            const char* a1 = cA + (size_t)(t + 1) * kstep;
            const char* a2 = last ? nA : cA + (size_t)(t + 2) * kstep; const char* b2 = last ? nB : cB + (size_t)(t + 2) * kstep;
            const char* a3 = a2 + kstep; const char* b3 = b2 + kstep;
            PG8_LDB(B0, 0, 0); PG8_LDB(B1, 0, 1); PG8_SCHED; PG8_LDA(At, 0, 0); PG8_STAGE(PG8_SA(1, 1), a1 + hstep, voffA);
            PG8_WAIT_V(8); PG8_WAIT_L(0); PG8_BAR; PG8_MMA(0, 0, At, B0); PG8_MMA(0, 1, At, B1); PG8_BAR; PG8_SCHED;
            PG8_LDA(At, 0, 1); PG8_STAGE(PG8_SB(0, 0), b2, voffB); PG8_STAGE(PG8_SB(0, 1), b2 + bhstep, voffB); PG8_STAGE(PG8_SA(0, 0), a2, voffA);
            PG8_WAIT_V(8); PG8_WAIT_L(0); PG8_BAR; PG8_MMA(1, 0, At, B0); PG8_MMA(1, 1, At, B1); PG8_BAR; PG8_SCHED;
            PG8_LDB(B0, 1, 0); PG8_LDB(B1, 1, 1); PG8_SCHED; PG8_LDA(At, 1, 0); PG8_STAGE(PG8_SA(0, 1), a2 + hstep, voffA);
            PG8_WAIT_V(8); PG8_WAIT_L(0); PG8_BAR; PG8_MMA(0, 0, At, B0); PG8_MMA(0, 1, At, B1); PG8_BAR; PG8_SCHED;
            PG8_LDA(At, 1, 1); PG8_STAGE(PG8_SB(1, 0), b3, voffB); PG8_STAGE(PG8_SB(1, 1), b3 + bhstep, voffB); PG8_STAGE(PG8_SA(1, 0), a3, voffA);
            PG8_WAIT_V(8); PG8_WAIT_L(0); PG8_BAR; PG8_MMA(1, 0, At, B0); PG8_MMA(1, 1, At, B1); PG8_BAR; PG8_SCHED;
        }
        if (wr == 0) PG8_BAR;
        E(acc, cur, wr, wc, fr, fq);
        if (!has_next) break;
#pragma unroll
        for (int a = 0; a < 2; ++a)
#pragma unroll
            for (int b = 0; b < 2; ++b)
#pragma unroll
                for (int m = 0; m < 4; ++m)
#pragma unroll
                    for (int n = 0; n < 2; ++n) acc[a][b][m][n] = (f32x4){0.f, 0.f, 0.f, 0.f};
        cur = nxt; cA = nA; cB = nB; ++ui;
        if (wr == 1) PG8_BAR;
    }
    PG8_WAIT_V(0);
    PG8_BAR;
#undef PG8_SA
#undef PG8_SB
#undef PG8_STAGE
#undef PG8_LDA
#undef PG8_LDB
#undef PG8_MMA
#undef PG8_WAIT_V
#undef PG8_WAIT_L
#undef PG8_BAR
#undef PG8_SCHED
}

struct EpiInProj {
    static constexpr bool PERM = true;
    bf16_t* P; const float* cs; const float* sn;
    __device__ __forceinline__ void operator()(const f32x4 (&acc)[2][2][4][2], const Unit& u, int wr, int wc, int fr, int fq) const {
        const int row0 = u.pm * BM + wr * 64 + fr, colt = u.pn * BM, i0 = wc * 32 + 8 * fq;
        const bool rot = u.pn < 8; const float ksc = (u.pn >= 4 && u.pn < 8) ? 0.0625f : 1.f;
#pragma unroll
        for (int ai = 0; ai < 2; ++ai)
#pragma unroll
            for (int m = 0; m < 4; ++m) {
                const int row = row0 + ai * HALF + m * 16;
                f32x4 a0 = acc[ai][0][m][0], a1 = acc[ai][0][m][1], b0 = acc[ai][1][m][0], b1 = acc[ai][1][m][1];
                if (rot) {
                    const f32x4 c0 = *(const f32x4*)(cs + (size_t)row * 128 + i0), c1 = *(const f32x4*)(cs + (size_t)row * 128 + i0 + 4);
                    const f32x4 s0 = *(const f32x4*)(sn + (size_t)row * 128 + i0), s1 = *(const f32x4*)(sn + (size_t)row * 128 + i0 + 4);
                    const f32x4 o0 = (a0 * c0 - b0 * s0) * ksc, o1 = (a1 * c1 - b1 * s1) * ksc, p0 = (a0 * s0 + b0 * c0) * ksc, p1 = (a1 * s1 + b1 * c1) * ksc;
                    a0 = o0; a1 = o1; b0 = p0; b1 = p1;
                }
                bf16_t* rp = P + (size_t)row * INC + colt + i0;
                *(u32x4*)rp = (u32x4){cvt_pk_bf16(a0[0], a0[1]), cvt_pk_bf16(a0[2], a0[3]), cvt_pk_bf16(a1[0], a1[1]), cvt_pk_bf16(a1[2], a1[3])};
                *(u32x4*)(rp + HALF) = (u32x4){cvt_pk_bf16(b0[0], b0[1]), cvt_pk_bf16(b0[2], b0[3]), cvt_pk_bf16(b1[0], b1[1]), cvt_pk_bf16(b1[2], b1[3])};
            }
    }
};
struct EpiOutProj {
    static constexpr bool PERM = false;
    const float* X; float* H;
    __device__ __forceinline__ void operator()(const f32x4 (&acc)[2][2][4][2], const Unit& u, int wr, int wc, int fr, int fq) const {
        const int row0 = u.pm * BM + wr * 64 + fr, col0 = u.pn * BM + wc * 32 + 4 * fq;
#pragma unroll
        for (int ai = 0; ai < 2; ++ai)
#pragma unroll
            for (int m = 0; m < 4; ++m) {
                const size_t ro = (size_t)(row0 + ai * HALF + m * 16) * DM + col0;
#pragma unroll
                for (int bj = 0; bj < 2; ++bj)
#pragma unroll
                    for (int n = 0; n < 2; ++n) { const f32x4 xv = *(const f32x4*)(X + ro + bj * HALF + n * 16); *(f32x4*)(H + ro + bj * HALF + n * 16) = acc[ai][bj][m][n] + xv; }
            }
    }
};
__device__ __forceinline__ float swiglu1(float g, float u) {
    g = fminf(g, 7.0f); u = fminf(fmaxf(u, -7.0f), 7.0f);
    const float sg = 1.0f / (1.0f + __expf(-1.702f * g));
    return (u + 1.0f) * g * sg;
}
struct EpiGateUp {
    static constexpr bool PERM = true;
    bf16_t* Hd; const float* bg; const float* bu;
    __device__ __forceinline__ void operator()(const f32x4 (&acc)[2][2][4][2], const Unit& u, int wr, int wc, int fr, int fq) const {
        const int row0 = u.pm * BM + wr * 64 + fr, colh = u.pn * HALF + wc * 32 + 8 * fq;
        const f32x4 g0 = *(const f32x4*)(bg + (size_t)u.e * 2048 + colh), g1 = *(const f32x4*)(bg + (size_t)u.e * 2048 + colh + 4);
        const f32x4 u0 = *(const f32x4*)(bu + (size_t)u.e * 2048 + colh), u1 = *(const f32x4*)(bu + (size_t)u.e * 2048 + colh + 4);
#pragma unroll
        for (int ai = 0; ai < 2; ++ai)
#pragma unroll
            for (int m = 0; m < 4; ++m) {
                const int row = row0 + ai * HALF + m * 16;
                const f32x4 ga = acc[ai][0][m][0] + g0, gb = acc[ai][0][m][1] + g1, ua = acc[ai][1][m][0] + u0, ub = acc[ai][1][m][1] + u1;
                float h[8];
#pragma unroll
                for (int j = 0; j < 4; ++j) { h[j] = swiglu1(ga[j], ua[j]); h[4 + j] = swiglu1(gb[j], ub[j]); }
                *(u32x4*)(Hd + (size_t)row * 2048 + colh) = (u32x4){cvt_pk_bf16(h[0], h[1]), cvt_pk_bf16(h[2], h[3]), cvt_pk_bf16(h[4], h[5]), cvt_pk_bf16(h[6], h[7])};
            }
    }
};
struct EpiDown {
    static constexpr bool PERM = true;
    bf16_t* Y; const float* bd; const float* sw;
    __device__ __forceinline__ void operator()(const f32x4 (&acc)[2][2][4][2], const Unit& u, int wr, int wc, int fr, int fq) const {
        const int row0 = u.pm * BM + wr * 64 + fr, col0 = u.pn * BM + wc * 32 + 8 * fq;
        f32x4 bv[2][2];
#pragma unroll
        for (int bj = 0; bj < 2; ++bj)
#pragma unroll
            for (int n = 0; n < 2; ++n) bv[bj][n] = *(const f32x4*)(bd + (size_t)u.e * 2048 + col0 + bj * HALF + 4 * n);
#pragma unroll
        for (int ai = 0; ai < 2; ++ai)
#pragma unroll
            for (int m = 0; m < 4; ++m) {
                const int row = row0 + ai * HALF + m * 16; const float w = sw[row];
#pragma unroll
                for (int bj = 0; bj < 2; ++bj) {
                    const f32x4 v0 = (acc[ai][bj][m][0] + bv[bj][0]) * w, v1 = (acc[ai][bj][m][1] + bv[bj][1]) * w;
                    *(u32x4*)(Y + (size_t)row * 2048 + col0 + bj * HALF) = (u32x4){cvt_pk_bf16(v0[0], v0[1]), cvt_pk_bf16(v0[2], v0[3]), cvt_pk_bf16(v1[0], v1[1]), cvt_pk_bf16(v1[2], v1[3])};
                }
            }
    }
};

struct Args { const float* in[16]; float* out; unsigned char* ws; int ph_lo, ph_hi; };
enum { I_X = 0, I_POS, I_G1, I_WIN, I_WOUT, I_RELB, I_G2, I_RW, I_RB, I_WG, I_BG, I_WU, I_BU, I_WD, I_BD, I_GF };

__device__ __forceinline__ void p0_transpose_item(const float* W, int N, bf16_t* WT, int kb, int nb, LAS unsigned* scr, int lane) {
    const int k0 = 128 * kb, n0 = 64 * nb, kq = lane >> 4, nq = lane & 15;
#pragma unroll
    for (int half = 0; half < 2; ++half) {
        f32x4 v[16];
#pragma unroll
        for (int i = 0; i < 16; ++i) { const int k = half * 64 + 2 * (kq + 4 * (i >> 1)) + (i & 1); v[i] = *(const f32x4*)(W + (size_t)(k0 + k) * N + n0 + 4 * nq); }
#pragma unroll
        for (int a = 0; a < 8; ++a)
#pragma unroll
            for (int j = 0; j < 4; ++j) scr[(4 * nq + j) * 68 + half * 32 + kq + 4 * a] = cvt_pk_bf16(v[2 * a][j], v[2 * a + 1][j]);
    }
    LDS_WAIT();
#pragma unroll
    for (int r = 0; r < 16; ++r) { const int n = 4 * r + kq; const u32x4 o = *(const LAS u32x4*)(scr + n * 68 + nq * 4); *(u32x4*)(WT + (size_t)(n0 + n) * KD + k0 + 8 * nq) = o; }
    LDS_WAIT();
}
__device__ __forceinline__ void sincos_d(double x, float& c, float& s) {
    const double TWO_OVER_PI = 0.63661977236758134308, P1 = 1.57079632673412561417e+00, P2 = 6.07710050650619224932e-11;
    const double fn = __builtin_rint(x * TWO_OVER_PI);
    double r = __builtin_fma(-fn, P1, x); r = __builtin_fma(-fn, P2, r);
    const int q = (int)((long long)fn & 3);
    const double z = r * r;
    double ps = -7.6471637318198164759e-13; ps = ps * z + 1.6059043836821614599e-10; ps = ps * z - 2.5052108385441718775e-08; ps = ps * z + 2.7557319223985890653e-06;
    ps = ps * z - 1.9841269841269841270e-04; ps = ps * z + 8.3333333333333333333e-03; ps = ps * z - 1.6666666666666666667e-01;
    const double sv = r + r * z * ps;
    double pc = 4.7794773323873852974e-14; pc = pc * z - 1.1470745597729724714e-11; pc = pc * z + 2.0876756987868098979e-09; pc = pc * z - 2.7557319223985890653e-07;
    pc = pc * z + 2.4801587301587301587e-05; pc = pc * z - 1.3888888888888888889e-03; pc = pc * z + 4.1666666666666666667e-02; pc = pc * z - 0.5;
    const double cv = 1.0 + z * pc;
    const double cc = (q == 0) ? cv : (q == 1) ? -sv : (q == 2) ? -cv : sv;
    const double ss = (q == 0) ? sv : (q == 1) ? cv : (q == 2) ? -sv : -cv;
    c = (float)cc; s = (float)ss;
}
__device__ __forceinline__ void p0_prologue(const Args& A, LAS unsigned char* lds, int wave, int lane, int vcu, int G) {
    unsigned char* ws = A.ws;
    LAS unsigned* scr = (LAS unsigned*)(lds + wave * 17408);
    const int gw = vcu * 8 + wave, NGW = G * 8;
    constexpr int I_IN = 16 * (INC / 64), I_OUT = 16 * 32, I_EXP = 16 * 32;
    constexpr int NITEMS = I_IN + I_OUT + 96 * I_EXP;
    for (int it = gw; it < NITEMS; it += NGW) {
        int r = it;
        if (r < I_IN) { p0_transpose_item(A.in[I_WIN], INC, (bf16_t*)(ws + WS_WIN), r / (INC / 64), r % (INC / 64), scr, lane); continue; } r -= I_IN;
        if (r < I_OUT) { p0_transpose_item(A.in[I_WOUT], DM, (bf16_t*)(ws + WS_WOUT), r / 32, r % 32, scr, lane); continue; } r -= I_OUT;
        const int mat = r / I_EXP, rr = r % I_EXP, which = mat / 32, e = mat % 32;
        const float* src = (which == 0 ? A.in[I_WG] : which == 1 ? A.in[I_WU] : A.in[I_WD]) + (size_t)e * 2048 * 2048;
        bf16_t* dst = (bf16_t*)(ws + (which == 0 ? WS_WG : which == 1 ? WS_WU : WS_WD)) + (size_t)e * 2048 * 2048;
        p0_transpose_item(src, 2048, dst, rr / 32, rr % 32, scr, lane);
    }
    const float* x = A.in[I_X]; const float* g1 = A.in[I_G1]; bf16_t* XN = (bf16_t*)(ws + WS_XN);
    for (int m = gw; m < NTOK; m += NGW) {
        const f32x4* xr = (const f32x4*)(x + (size_t)m * DM) + lane;
        f32x4 v[8]; float s = 0.f;
#pragma unroll
        for (int j = 0; j < 8; ++j) { v[j] = xr[64 * j]; s += (v[j].x * v[j].x + v[j].y * v[j].y) + (v[j].z * v[j].z + v[j].w * v[j].w); }
        const float rstd = 1.0f / sqrtf(wave_sum(s) * (1.f / DM) + NORM_EPS);
        u32x2* o8 = (u32x2*)(XN + (size_t)m * DM) + lane;
#pragma unroll
        for (int j = 0; j < 8; ++j) { const f32x4 g = ((const f32x4*)g1)[lane + 64 * j]; const f32x4 y = v[j] * rstd * g; o8[64 * j] = (u32x2){cvt_pk_bf16(y.x, y.y), cvt_pk_bf16(y.z, y.w)}; }
    }
    const int* pos = (const int*)A.in[I_POS]; float* CS = (float*)(ws + WS_COS); float* SN = (float*)(ws + WS_SIN);
    for (int idx = (vcu * 512 + (int)threadIdx.x); idx < NTOK * 128; idx += G * 512) {
        const int m = idx >> 7, i = idx & 127;
        const float pw = (float)exp2((double)i * (13.287712379549449 / 128.0));
        const float invf = 1.0f / pw;
        const float ang = (float)pos[m] * invf;
        float c, s; sincos_d((double)ang, c, s);
        CS[idx] = c; SN[idx] = s;
    }
}

template <int D> struct BandCfg { static constexpr int KSTR = D * 2 + 16, VSTR = D * 2 + 32, KBYTES = 64 * KSTR, VBYTES = 64 * VSTR, NS = D / 32, NDT = D / 16, NPC = (64 * D * 2 / 16) / 512; };

__device__ constexpr double kLog2Gamma[4] = { -0.04580368961312479, -0.018003552928331026, -0.007117849617096985, -0.0028205190623786626 };

template <int D, bool ATT>
__device__ __forceinline__ void band_unit(const Args& A, LAS unsigned char* lds, int b, int h, int cq, int wave, int lane) {
    typedef BandCfg<D> C;
    const bf16_t* PROJ = (const bf16_t*)(A.ws + WS_PROJ);
    bf16_t* MIX = (bf16_t*)(A.ws + WS_MIX);
    const int tid = threadIdx.x, qt = wave & 3, kh = wave >> 2, g4 = lane >> 4, li = lane & 15;
    const int qoff = ATT ? OFF_AQ + h * 128 : OFF_RQ + h * 256, koff = ATT ? OFF_AK + h * 128 : OFF_RK + h * 256, voff = ATT ? OFF_AV + h * 128 : OFF_RV + h * 256;
    const int tok_q0 = b * SEQ + cq * CH, qrow = tok_q0 + 16 * qt + li, nq = 16 * qt + li;
    LAS unsigned char* KS = lds; LAS unsigned char* VS = lds + C::KBYTES;
    LAS float* btab = (LAS float*)(lds + TAB_OFF + 1024);
    if (ATT) { if (tid < 320) btab[tid] = A.in[I_RELB][h * 320 + tid] * 1.4426950408889634f; }
    bf16x8 Qf[C::NS];
#pragma unroll
    for (int s = 0; s < C::NS; ++s) Qf[s] = *(const bf16x8*)(PROJ + (size_t)qrow * INC + qoff + 32 * s + 8 * g4);
    f32x4 O[C::NDT];
#pragma unroll
    for (int d = 0; d < C::NDT; ++d) O[d] = (f32x4){0.f, 0.f, 0.f, 0.f};
    float mrun = -1e30f, lsum = 0.f;
    const float l2g = ATT ? 0.f : (float)kLog2Gamma[h];
    const int kc_lo = ATT ? (cq > 8 ? cq - 8 : 0) : 0;
    u32x4 kreg[C::NPC], vreg[C::NPC];
#define BAND_ISSUE(kc_) do { const size_t tok0_ = (size_t)b * SEQ + (size_t)(kc_) * CH; \
        _Pragma("unroll") for (int i = 0; i < C::NPC; ++i) { const int p_ = tid + 512 * i, row_ = p_ / (D / 8), c_ = p_ % (D / 8); \
            kreg[i] = *(const u32x4*)(PROJ + (tok0_ + row_) * INC + koff + 8 * c_); vreg[i] = *(const u32x4*)(PROJ + (tok0_ + row_) * INC + voff + 8 * c_); } } while (0)
    BAND_ISSUE(kc_lo);
    for (int kc = kc_lo; kc <= cq; ++kc) {
#pragma unroll
        for (int i = 0; i < C::NPC; ++i) { const int p = tid + 512 * i, row = p / (D / 8), c = p % (D / 8);
            *(LAS u32x4*)(KS + row * C::KSTR + c * 16) = kreg[i]; *(LAS u32x4*)(VS + row * C::VSTR + c * 16) = vreg[i]; }
        if (kc < cq) BAND_ISSUE(kc + 1);
        __syncthreads();
        f32x4 S0 = (f32x4){0.f, 0.f, 0.f, 0.f}, S1 = S0;
#pragma unroll
        for (int s = 0; s < C::NS; ++s) {
            const bf16x8 k0 = *(const LAS bf16x8*)(KS + (32 * kh + li) * C::KSTR + (32 * s + 8 * g4) * 2);
            const bf16x8 k1 = *(const LAS bf16x8*)(KS + (32 * kh + 16 + li) * C::KSTR + (32 * s + 8 * g4) * 2);
            S0 = __builtin_amdgcn_mfma_f32_16x16x32_bf16(k0, Qf[s], S0, 0, 0, 0);
            S1 = __builtin_amdgcn_mfma_f32_16x16x32_bf16(k1, Qf[s], S1, 0, 0, 0);
        }
        const int rel0 = 64 * (cq - kc) + nq - (32 * kh + 4 * g4);
        float p[8];
        if (ATT) {
            float sc[8];
#pragma unroll
            for (int r = 0; r < 4; ++r) {
                int i0 = rel0 - r; i0 = (i0 > 256 ? 256 : i0) + 63; int i1 = rel0 - 16 - r; i1 = (i1 > 256 ? 256 : i1) + 63;
                sc[r] = S0[r] * (0.08838834764831845f * 1.4426950408889634f) + btab[i0];
                sc[4 + r] = S1[r] * (0.08838834764831845f * 1.4426950408889634f) + btab[i1];
            }
            float mx = fmaxf(fmaxf(fmaxf(sc[0], sc[1]), fmaxf(sc[2], sc[3])), fmaxf(fmaxf(sc[4], sc[5]), fmaxf(sc[6], sc[7])));
            mx = fmaxf(mx, __shfl_xor(mx, 16)); mx = fmaxf(mx, __shfl_xor(mx, 32));
            const float mnew = fmaxf(mrun, mx), alpha = __builtin_amdgcn_exp2f(mrun - mnew);
            float ps = 0.f;
#pragma unroll
            for (int r = 0; r < 8; ++r) { p[r] = __builtin_amdgcn_exp2f(sc[r] - mnew); ps += p[r]; }
            lsum = lsum * alpha + ps; mrun = mnew;
#pragma unroll
            for (int d = 0; d < C::NDT; ++d) O[d] = O[d] * alpha;
        } else {
#pragma unroll
            for (int r = 0; r < 4; ++r) {
                int d0 = rel0 - r; d0 = d0 < 0 ? -d0 : d0; int d1 = rel0 - 16 - r; d1 = d1 < 0 ? -d1 : d1;
                p[r] = S0[r] * __builtin_amdgcn_exp2f(l2g * (float)d0); p[4 + r] = S1[r] * __builtin_amdgcn_exp2f(l2g * (float)d1);
            }
        }
        bf16x8 Pf; { const u32x4 pk = (u32x4){cvt_pk_bf16(p[0], p[1]), cvt_pk_bf16(p[2], p[3]), cvt_pk_bf16(p[4], p[5]), cvt_pk_bf16(p[6], p[7])}; Pf = __builtin_bit_cast(bf16x8, pk); }
        LAS unsigned char* vb = VS + (32 * kh + 4 * g4 + (li >> 2)) * C::VSTR + 8 * (li & 3);
#pragma unroll
        for (int d = 0; d < C::NDT; ++d) {
            const s16x4 lo = __builtin_amdgcn_ds_read_tr16_b64_v4i16((LAS s16x4*)(vb + 32 * d));
            const s16x4 hi = __builtin_amdgcn_ds_read_tr16_b64_v4i16((LAS s16x4*)(vb + 16 * C::VSTR + 32 * d));
            const bf16x8 Vf = __builtin_shufflevector(lo, hi, 0, 1, 2, 3, 4, 5, 6, 7);
            O[d] = __builtin_amdgcn_mfma_f32_16x16x32_bf16(Vf, Pf, O[d], 0, 0, 0);
        }
        __syncthreads();
    }
    if (ATT) { lsum += __shfl_xor(lsum, 16); lsum += __shfl_xor(lsum, 32); }
    LAS f32x4* xo = (LAS f32x4*)(lds + qt * (C::NDT * 1024 + 512));
    LAS float* xm = (LAS float*)(lds + qt * (C::NDT * 1024 + 512) + C::NDT * 1024);
    if (kh == 1) {
#pragma unroll
        for (int d = 0; d < C::NDT; ++d) xo[d * 64 + lane] = O[d];
        if (ATT) { xm[lane] = mrun; xm[64 + lane] = lsum; }
    }
    __syncthreads();
    if (kh == 0) {
        float a0 = 1.f, a1 = 1.f, linv = 1.f;
        if (ATT) { const float m1 = xm[lane], l1 = xm[64 + lane], mm = fmaxf(mrun, m1); a0 = __builtin_amdgcn_exp2f(mrun - mm); a1 = __builtin_amdgcn_exp2f(m1 - mm); linv = 1.0f / (lsum * a0 + l1 * a1); a0 *= linv; a1 *= linv; }
        float ss = 0.f;
#pragma unroll
        for (int d = 0; d < C::NDT; ++d) { const f32x4 o1 = xo[d * 64 + lane]; O[d] = ATT ? (O[d] * a0 + o1 * a1) : (O[d] + o1); ss += (O[d].x * O[d].x + O[d].y * O[d].y) + (O[d].z * O[d].z + O[d].w * O[d].w); }
        if (ATT) {
            bf16_t* op = MIX + (size_t)qrow * DM + 1024 + h * 128 + 4 * g4;
#pragma unroll
            for (int d = 0; d < C::NDT; ++d) *(u32x2*)(op + 16 * d) = (u32x2){cvt_pk_bf16(O[d].x, O[d].y), cvt_pk_bf16(O[d].z, O[d].w)};
        } else {
            ss += __shfl_xor(ss, 16); ss += __shfl_xor(ss, 32);
            const float rinv = 1.0f / sqrtf(ss * (1.f / 256.f) + NORM_EPS);
            const bf16_t* gp = PROJ + (size_t)qrow * INC + OFF_RG + h * 256 + 4 * g4;
            bf16_t* op = MIX + (size_t)qrow * DM + h * 256 + 4 * g4;
#pragma unroll
            for (int d = 0; d < C::NDT; ++d) {
                const u32x2 gv = *(const u32x2*)(gp + 16 * d);
                const float ga = bf_lo(gv.x), gb = bf_hi(gv.x), gc = bf_lo(gv.y), gd = bf_hi(gv.y);
                const float ya = O[d].x * rinv * (ga / (1.0f + __expf(-ga))), yb = O[d].y * rinv * (gb / (1.0f + __expf(-gb)));
                const float yc = O[d].z * rinv * (gc / (1.0f + __expf(-gc))), yd = O[d].w * rinv * (gd / (1.0f + __expf(-gd)));
                *(u32x2*)(op + 16 * d) = (u32x2){cvt_pk_bf16(ya, yb), cvt_pk_bf16(yc, yd)};
            }
        }
    }
    __syncthreads();
#undef BAND_ISSUE
}

__device__ __forceinline__ void p2_mixers(const Args& A, LAS unsigned char* lds, int wave, int lane) {
    unsigned* ctl = (unsigned*)(A.ws + WS_CTL);
    volatile LAS unsigned* wq = (volatile LAS unsigned*)(lds + CTL_OFF + 64);
    for (;;) {
        if (threadIdx.x == 0) wq[0] = __hip_atomic_fetch_add(ctl + CW_WQ, 1u, RLX_AGENT);
        __syncthreads();
        const unsigned u = wq[0];
        __syncthreads();
        if (u >= 1536u) break;
        if (u < 512u) { const int cq = 31 - (int)(u >> 4), bh = (int)(u & 15); band_unit<256, false>(A, lds, bh >> 2, bh & 3, cq, wave, lane); }
        else { const unsigned v = u - 512u; const int cq = 31 - (int)(v >> 5), bh = (int)(v & 31); band_unit<128, true>(A, lds, bh >> 3, bh & 7, cq, wave, lane); }
    }
}

__device__ __forceinline__ void p4_router(const Args& A, LAS unsigned char* lds, int wave, int lane, int G) {
    const float* H1 = (const float*)(A.ws + WS_H1); const float* g2 = A.in[I_G2]; const float* RW = A.in[I_RW]; const float* RB = A.in[I_RB];
    unsigned char* rt = A.ws + WS_RT;
    int* TOPE = (int*)(rt + RT_TOPE); float* TOPW = (float*)(rt + RT_TOPW); float* RSTD = (float*)(rt + RT_RSTD); int* LRANK = (int*)(rt + RT_LRANK); int* HIST = (int*)(rt + RT_HIST);
    const int tid = threadIdx.x;
    LAS float* Ast = (LAS float*)lds;
    LAS float* part = (LAS float*)(lds + 66048);
    LAS float* lg = (LAS float*)(lds + 66048 + 32768);
    LAS float* ssqp = (LAS float*)(lds + 66048 + 32768 + 4352);
    LAS float* rs = ssqp + 64;
    LAS int* esel = (LAS int*)(rs + 32);
    for (int blk = blockIdx.x; blk < NTOK / 32; blk += G) {
        const int tok0 = blk * 32;
        f32x16 acc;
#pragma unroll
        for (int i = 0; i < 16; ++i) acc[i] = 0.f;
        float ss[8];
#pragma unroll
        for (int i = 0; i < 8; ++i) ss[i] = 0.f;
        for (int kc = 0; kc < 4; ++kc) {
#pragma unroll
            for (int i = 0; i < 8; ++i) {
                const int idx = tid + 512 * i, tok = idx >> 7, c4 = idx & 127;
                f32x4 v = *(const f32x4*)(H1 + (size_t)(tok0 + tok) * DM + kc * 512 + c4 * 4);
                ss[i] += (v.x * v.x + v.y * v.y) + (v.z * v.z + v.w * v.w);
                const f32x4 g = *(const f32x4*)(g2 + kc * 512 + c4 * 4); v = v * g;
                LAS float* d = Ast + tok * 513 + c4 * 4; d[0] = v.x; d[1] = v.y; d[2] = v.z; d[3] = v.w;
            }
            __syncthreads();
#pragma unroll 8
            for (int kk = 0; kk < 32; ++kk) {
                const int k = 64 * wave + 2 * kk + (lane >> 5);
                const float a = Ast[(lane & 31) * 513 + k];
                const float bb = RW[(size_t)(kc * 512 + k) * 32 + (lane & 31)];
                acc = __builtin_amdgcn_mfma_f32_32x32x2f32(a, bb, acc, 0, 0, 0);
            }
            __syncthreads();
        }
#pragma unroll
        for (int i = 0; i < 8; ++i) { const float s = wave_sum(ss[i]); if (lane == 0) ssqp[wave * 8 + i] = s; }
#pragma unroll
        for (int r = 0; r < 16; ++r) part[(wave * 32 + ((r & 3) + 8 * (r >> 2) + 4 * (lane >> 5))) * 32 + (lane & 31)] = acc[r];
        __syncthreads();
        if (tid < 32) { const int w0 = 2 * (tid & 3), i = tid >> 2; const float q = ssqp[w0 * 8 + i] + ssqp[(w0 + 1) * 8 + i]; const float r = 1.0f / sqrtf(q * (1.f / DM) + NORM_EPS); rs[tid] = r; RSTD[tok0 + tid] = r; }
        __syncthreads();
#pragma unroll
        for (int pp = 0; pp < 2; ++pp) {
            const int p = tid + 512 * pp, tok = p >> 5, j = p & 31; float s = 0.f;
#pragma unroll
            for (int w = 0; w < 8; ++w) s += part[(w * 32 + tok) * 32 + j];
            lg[tok * 33 + j] = s * rs[tok] + RB[j];
        }
        __syncthreads();
        if (tid < 32) {
            unsigned taken = 0u; float lv[4]; int le[4];
#pragma unroll
            for (int k = 0; k < 4; ++k) {
                float best = -3.0e38f; int bi = 0;
                for (int j = 0; j < 32; ++j) { const float xv = lg[tid * 33 + j]; const bool ok = !((taken >> j) & 1u) && xv > best; best = ok ? xv : best; bi = ok ? j : bi; }
                taken |= 1u << bi; lv[k] = best; le[k] = bi;
            }
            const float e1 = __expf(lv[1] - lv[0]), e2 = __expf(lv[2] - lv[0]), e3 = __expf(lv[3] - lv[0]); const float inv = 1.0f / (1.0f + e1 + e2 + e3);
            const float wv[4] = {inv, e1 * inv, e2 * inv, e3 * inv};
#pragma unroll
            for (int k = 0; k < 4; ++k) { TOPE[(tok0 + tid) * 4 + k] = le[k]; TOPW[(tok0 + tid) * 4 + k] = wv[k]; esel[tid * 4 + k] = le[k]; }
        }
        __syncthreads();
        if (tid < 32) { int cnt = 0;
            for (int a = 0; a < 128; ++a) { if (esel[a] == tid) { LRANK[tok0 * 4 + a] = cnt; ++cnt; } }
            HIST[blk * 32 + tid] = cnt; }
        __syncthreads();
    }
}

__device__ __forceinline__ void p5_scatter(const Args& A, LAS unsigned char* lds, int wave, int lane, int G) {
    const float* H1 = (const float*)(A.ws + WS_H1); const float* g2 = A.in[I_G2];
    unsigned char* rt = A.ws + WS_RT; unsigned* ctl = (unsigned*)(A.ws + WS_CTL);
    const int* TOPE = (const int*)(rt + RT_TOPE); const float* TOPW = (const float*)(rt + RT_TOPW); const float* RSTD = (const float*)(rt + RT_RSTD); const int* LRANK = (const int*)(rt + RT_LRANK); const int* HIST = (const int*)(rt + RT_HIST);
    int* TOKPOS = (int*)(rt + RT_TOKPOS); float* SLOTW = (float*)(rt + RT_SLOTW);
    bf16_t* XG = (bf16_t*)(A.ws + WS_XG);
    const int tid = threadIdx.x;
    LAS int* psum = (LAS int*)lds; LAS int* pin = psum + 512; LAS int* cnt = pin + 512; LAS int* pad = cnt + 32; LAS int* pst = pad + 32; LAS int* basee = pst + 32;
    for (int blk = blockIdx.x; blk < NTOK / 32; blk += G) {
        const int tok0 = blk * 32;
        { const int e = tid & 31, pt = tid >> 5; int s = 0, inp = 0;
            for (int bb = 0; bb < 16; ++bb) { const int b2 = pt * 16 + bb; const int c = HIST[b2 * 32 + e]; s += c; inp += (b2 < blk) ? c : 0; }
            psum[pt * 32 + e] = s; pin[pt * 32 + e] = inp; }
        __syncthreads();
        if (tid < 32) { int tot = 0, bs = 0; for (int pt = 0; pt < 16; ++pt) { tot += psum[pt * 32 + tid]; bs += pin[pt * 32 + tid]; } cnt[tid] = tot; pad[tid] = (tot + 255) & ~255; basee[tid] = bs; }
        __syncthreads();
        if (tid < 32) { int ps = 0; for (int e = 0; e < tid; ++e) ps += pad[e]; pst[tid] = ps; basee[tid] += ps; }
        __syncthreads();
        if (blk == 0 && tid == 0) { int mt = 0; for (int e = 0; e < 32; ++e) { const int n = pad[e] >> 8; for (int i = 0; i < n; ++i) { __hip_atomic_store(ctl + CW_MTE + mt, (unsigned)e, RLX_AGENT); ++mt; } } __hip_atomic_store(ctl + CW_NMT, (unsigned)mt, RLX_AGENT); }
        for (int i = 0; i < 4; ++i) {
            const int tok = tok0 + 4 * wave + i;
            int pos = 0;
            if (lane < 4) { const int e = TOPE[tok * 4 + lane]; pos = basee[e] + LRANK[tok * 4 + lane]; TOKPOS[tok * 4 + lane] = pos; SLOTW[pos] = TOPW[tok * 4 + lane]; }
            const int p0 = __shfl(pos, 0), p1 = __shfl(pos, 1), p2 = __shfl(pos, 2), p3 = __shfl(pos, 3);
            const float rstd = RSTD[tok];
            const f32x4* xr = (const f32x4*)(H1 + (size_t)tok * DM) + lane;
#pragma unroll
            for (int j = 0; j < 8; ++j) {
                const f32x4 g = ((const f32x4*)g2)[lane + 64 * j]; const f32x4 y = xr[64 * j] * rstd * g;
                const u32x2 o = (u32x2){cvt_pk_bf16(y.x, y.y), cvt_pk_bf16(y.z, y.w)};
                ((u32x2*)(XG + (size_t)p0 * DM))[lane + 64 * j] = o; ((u32x2*)(XG + (size_t)p1 * DM))[lane + 64 * j] = o;
                ((u32x2*)(XG + (size_t)p2 * DM))[lane + 64 * j] = o; ((u32x2*)(XG + (size_t)p3 * DM))[lane + 64 * j] = o;
            }
        }
        if (blk < 32) {
            const int r0 = pst[blk] + cnt[blk], r1 = pst[blk] + pad[blk];
            for (int r = r0 + wave; r < r1; r += 8) {
                u32x4* o = (u32x4*)(XG + (size_t)r * DM);
#pragma unroll
                for (int j = 0; j < 4; ++j) o[lane + 64 * j] = (u32x4){0u, 0u, 0u, 0u};
                if (lane == 0) SLOTW[r] = 0.f;
            }
        }
        __syncthreads();
    }
}

__device__ __forceinline__ void p8_final(const Args& A, int wave, int lane, int vcu, int G) {
    const float* H1 = (const float*)(A.ws + WS_H1); const float* gf = A.in[I_GF]; const bf16_t* YB = (const bf16_t*)(A.ws + WS_YB);
    const int* TOKPOS = (const int*)(A.ws + WS_RT + RT_TOKPOS);
    const int gw = vcu * 8 + wave, NGW = G * 8;
    for (int tok = gw; tok < NTOK; tok += NGW) {
        int pos = 0; if (lane < 4) pos = TOKPOS[tok * 4 + lane];
        const int p0 = __shfl(pos, 0), p1 = __shfl(pos, 1), p2 = __shfl(pos, 2), p3 = __shfl(pos, 3);
        const f32x4* xr = (const f32x4*)(H1 + (size_t)tok * DM) + lane;
        const u32x2* y0 = (const u32x2*)(YB + (size_t)p0 * DM) + lane; const u32x2* y1 = (const u32x2*)(YB + (size_t)p1 * DM) + lane;
        const u32x2* y2 = (const u32x2*)(YB + (size_t)p2 * DM) + lane; const u32x2* y3 = (const u32x2*)(YB + (size_t)p3 * DM) + lane;
        f32x4 v[8]; float s = 0.f;
#pragma unroll
        for (int j = 0; j < 8; ++j) {
            const u32x2 a = y0[64 * j], b = y1[64 * j], c = y2[64 * j], d = y3[64 * j];
            f32x4 y;
            y.x = (bf_lo(a.x) + bf_lo(b.x)) + (bf_lo(c.x) + bf_lo(d.x)); y.y = (bf_hi(a.x) + bf_hi(b.x)) + (bf_hi(c.x) + bf_hi(d.x));
            y.z = (bf_lo(a.y) + bf_lo(b.y)) + (bf_lo(c.y) + bf_lo(d.y)); y.w = (bf_hi(a.y) + bf_hi(b.y)) + (bf_hi(c.y) + bf_hi(d.y));
            v[j] = xr[64 * j] + y;
            s += (v[j].x * v[j].x + v[j].y * v[j].y) + (v[j].z * v[j].z + v[j].w * v[j].w);
        }
        const float rstd = 1.0f / sqrtf(wave_sum(s) * (1.f / DM) + NORM_EPS);
        f32x4* o = (f32x4*)(A.out + (size_t)tok * DM) + lane;
#pragma unroll
        for (int j = 0; j < 8; ++j) o[64 * j] = v[j] * rstd * ((const f32x4*)gf)[lane + 64 * j];
    }
}

__global__ void __launch_bounds__(512, 2) hybrid_fwd(Args args) {
    extern __shared__ __attribute__((aligned(16))) unsigned char lds_raw[];
    LAS unsigned char* lds = (LAS unsigned char*)lds_raw;
    const int tid = threadIdx.x, lane = tid & 63, wave = __builtin_amdgcn_readfirstlane(tid >> 6);
    const int G = gridDim.x; const int bx = blockIdx.x; const int vcu = (G % 8 == 0) ? (bx % 8) * (G / 8) + bx / 8 : bx;
    unsigned char* ws = args.ws;
    unsigned* ctl = (unsigned*)(ws + WS_CTL);
    for (int u = tid; u < 256; u += 512) ((LAS unsigned*)(lds + CTL_OFF))[u] = 0u;
    __syncthreads();
    const int lo = args.ph_lo, hi = args.ph_hi;
    const bool multi = (hi - lo) > 1;
    XcdBarrier bar; bar.bar = ctl + CW_BAR; bar.x = 0; bar.st = nullptr;
    if (multi) bar = xcd_barrier_post(ctl + CW_BAR, (volatile LAS unsigned*)(lds + CTL_OFF));
#define IN(k) (lo <= (k) && (k) < hi)
#define SEAM(k) do { if (IN(k) && IN((k) + 1)) xcd_barrier(bar); } while (0)

    if (IN(0)) { p0_prologue(args, lds, wave, lane, vcu, G); }
    SEAM(0);
    if (IN(1)) {
        DenseOrder S; S.init(ws + WS_XN, ws + WS_WIN, NTOK, INC, G, bx);
        EpiInProj E{(bf16_t*)(ws + WS_PROJ), (const float*)(ws + WS_COS), (const float*)(ws + WS_SIN)};
        gemm_phase<EpiInProj, DenseOrder>(lds + RING_OFF, S, E, (size_t)HALF * KD * 2);
    }
    SEAM(1);
    if (IN(2)) { p2_mixers(args, lds, wave, lane); }
    SEAM(2);
    if (IN(3)) {
        DenseOrder S; S.init(ws + WS_MIX, ws + WS_WOUT, NTOK, DM, G, bx);
        EpiOutProj E{args.in[I_X], (float*)(ws + WS_H1)};
        gemm_phase<EpiOutProj, DenseOrder>(lds + RING_OFF, S, E, (size_t)HALF * KD * 2);
    }
    SEAM(3);
    if (IN(4)) { p4_router(args, lds, wave, lane, G); }
    SEAM(4);
    if (IN(5)) { p5_scatter(args, lds, wave, lane, G); }
    SEAM(5);
    if (IN(6) || IN(7)) {
        LAS int* mte = (LAS int*)(lds + TAB_OFF);
        if (tid < MAXMT) mte[tid] = (int)ld_u32_agent(ctl + CW_MTE + tid);
        if (tid == 0) mte[MAXMT] = (int)ld_u32_agent(ctl + CW_NMT);
        __syncthreads();
    }
    if (IN(6)) {
        const LAS int* mte = (const LAS int*)(lds + TAB_OFF);
        MoeOrder<16, 128> S; S.A = (const char*)(ws + WS_XG); S.B = (const char*)(ws + WS_WG); S.mte = mte; S.nmt = __builtin_amdgcn_readfirstlane(mte[MAXMT]); S.G = G; S.c = bx;
        EpiGateUp E{(bf16_t*)(ws + WS_HID), args.in[I_BG], args.in[I_BU]};
        gemm_phase<EpiGateUp, MoeOrder<16, 128>>(lds + RING_OFF, S, E, (size_t)(WS_WU - WS_WG));
    }
    SEAM(6);
    if (IN(7)) {
        const LAS int* mte = (const LAS int*)(lds + TAB_OFF);
        MoeOrder<8, 256> S; S.A = (const char*)(ws + WS_HID); S.B = (const char*)(ws + WS_WD); S.mte = mte; S.nmt = __builtin_amdgcn_readfirstlane(mte[MAXMT]); S.G = G; S.c = bx;
        EpiDown E{(bf16_t*)(ws + WS_YB), args.in[I_BD], (const float*)(ws + WS_RT + RT_SLOTW)};
        gemm_phase<EpiDown, MoeOrder<8, 256>>(lds + RING_OFF, S, E, (size_t)HALF * KD * 2);
    }
    SEAM(7);
    if (IN(8)) { p8_final(args, wave, lane, vcu, G); }
#undef IN
#undef SEAM
}
}

#ifndef N_LAUNCHES
#define N_LAUNCHES 1
#endif

extern "C" void kernel_launch(void* const* d_in, const int* in_sizes, int n_in, void* d_out, int out_size, void* d_ws, size_t ws_size, hipStream_t stream) {
    static int grid = 0;
    if (grid == 0) {
        if (n_in != 16 || out_size != NTOK * DM || ws_size < WS_END) { fprintf(stderr, "kernel_launch: unexpected shapes (n_in %d out %d ws %zu)\n", n_in, out_size, ws_size); grid = -1; return; }
        int dev = 0, cus = 0, per_cu = 0;
        if (hipGetDevice(&dev) != hipSuccess || hipDeviceGetAttribute(&cus, hipDeviceAttributeMultiprocessorCount, dev) != hipSuccess) { grid = -1; return; }
        if (hipFuncSetAttribute((const void*)hybrid_fwd, hipFuncAttributeMaxDynamicSharedMemorySize, LDS_BYTES) != hipSuccess) { fprintf(stderr, "kernel_launch: hipFuncSetAttribute failed\n"); grid = -1; return; }
        if (hipOccupancyMaxActiveBlocksPerMultiprocessor(&per_cu, (const void*)hybrid_fwd, 512, LDS_BYTES) != hipSuccess || per_cu < 1) { fprintf(stderr, "kernel_launch: occupancy query says %d\n", per_cu); (void)hipGetLastError(); per_cu = 1; }
        grid = cus;
    }
    if (grid < 0) return;
    (void)in_sizes;
    if (hipMemsetAsync((char*)d_ws + WS_CTL, 0, CTL_ZERO_BYTES, stream) != hipSuccess) { fprintf(stderr, "kernel_launch: memset failed\n"); return; }
    Args a{};
    for (int i = 0; i < 16; ++i) a.in[i] = (const float*)d_in[i];
    a.out = (float*)d_out; a.ws = (unsigned char*)d_ws;
#if N_LAUNCHES == 1
    a.ph_lo = 0; a.ph_hi = NPHASE;
    hipLaunchKernelGGL(hybrid_fwd, dim3(grid), dim3(512), LDS_BYTES, stream, a);
#else
    for (int p = 0; p < NPHASE; ++p) { a.ph_lo = p; a.ph_hi = p + 1; hipLaunchKernelGGL(hybrid_fwd, dim3(grid), dim3(512), LDS_BYTES, stream, a); }
#endif
    const hipError_t le = hipPeekAtLastError();
    if (le != hipSuccess) fprintf(stderr, "kernel_launch: launch failed: %s\n", hipGetErrorName(le));
}
```

```cpp
#include <hip/hip_runtime.h>
#include <cstdio>
#include <cstdint>

namespace {
#define GAS __attribute__((address_space(1)))
#define LAS __attribute__((address_space(3)))
typedef unsigned short bf16_t;
typedef short bf16x8 __attribute__((ext_vector_type(8)));
typedef short s16x4 __attribute__((ext_vector_type(4)));
typedef float f32x4 __attribute__((ext_vector_type(4)));
typedef float f32x16 __attribute__((ext_vector_type(16)));
typedef unsigned u32x4 __attribute__((ext_vector_type(4)));
typedef unsigned u32x2 __attribute__((ext_vector_type(2)));
typedef int i32x8 __attribute__((ext_vector_type(8)));
typedef int i32x4 __attribute__((ext_vector_type(4)));

constexpr int NTOK = 8192, DM = 2048, SEQ = 2048, NBATCH = 4, NCH = 32, CH = 64;
constexpr int INC = 7168;
constexpr int OFF_RQ = 0, OFF_RK = 1024, OFF_RV = 2048, OFF_RG = 3072, OFF_AQ = 4096, OFF_AK = 5120, OFF_AV = 6144;
constexpr int NEXP = 32, TOPK = 4, MAXMT = 160, MAXSLOT = MAXMT * 256;
constexpr float NORM_EPS = 1e-6f;
constexpr int NPHASE = 9;
constexpr int KD = 2048;

constexpr size_t MiB = 1u << 20;
constexpr size_t WS_CTL = 0, CTL_ZERO_BYTES = 1 * MiB;
constexpr size_t WS_XN = 1 * MiB;
constexpr size_t WS_WIN = 33 * MiB;
constexpr size_t WS_WOUT = 61 * MiB;
constexpr size_t WS_WG = 69 * MiB;
constexpr size_t WS_WU = 325 * MiB;
constexpr size_t WS_WD = 581 * MiB;
constexpr size_t WS_COS = 837 * MiB;
constexpr size_t WS_SIN = 841 * MiB;
constexpr size_t WS_PROJ = 845 * MiB;
constexpr size_t WS_MIX = 957 * MiB;
constexpr size_t WS_H1 = 989 * MiB;
constexpr size_t WS_RT = 1053 * MiB;
constexpr size_t WS_XG = 1055 * MiB;
constexpr size_t WS_HID = 1215 * MiB;
constexpr size_t WS_YB = 1375 * MiB;
constexpr size_t WS_END = 1535 * MiB;
constexpr size_t RT_TOPE = 0, RT_TOPW = 128 * 1024, RT_RSTD = 256 * 1024, RT_LRANK = 384 * 1024, RT_HIST = 512 * 1024, RT_TOKPOS = 640 * 1024, RT_SLOTW = 768 * 1024, RT_RWT = 1024 * 1024;
constexpr int CW_TMO = 0, CW_BAR = 4096, CW_WQ = 8192, CW_NMT = 8256, CW_MTE = 8320, CW_CQ = 8512, CW_CQD = 8576, CW_CQR = 8640, CW_BARW = 12288;
constexpr int MOE_EST = 512, MOE_ECN = 544;
constexpr int NG6 = 216;
constexpr int NG1 = 192;

constexpr int RING_OFF = 0, RING_BYTES = 131072;
constexpr int TAB_OFF = 147456;
constexpr int CTL_OFF = 151552;
constexpr int LDS_BYTES = 152576;

#define LDS_WAIT() asm volatile("s_waitcnt lgkmcnt(0)" ::: "memory")
#define VM_WAIT() asm volatile("s_waitcnt vmcnt(0)" ::: "memory")
#define RLX_AGENT __ATOMIC_RELAXED, __HIP_MEMORY_SCOPE_AGENT

__device__ __forceinline__ unsigned cvt_pk_bf16(float lo, float hi) { unsigned r; asm volatile("v_cvt_pk_bf16_f32 %0, %1, %2" : "=v"(r) : "v"(lo), "v"(hi)); return r; }
__device__ __forceinline__ unsigned cvt_pk4_fp8(float a, float b, float c, float d) { int p = 0; p = __builtin_amdgcn_cvt_pk_fp8_f32(a, b, p, false); p = __builtin_amdgcn_cvt_pk_fp8_f32(c, d, p, true); return (unsigned)p; }
__device__ __forceinline__ float bf_lo(unsigned u) { return __builtin_bit_cast(float, u << 16); }
__device__ __forceinline__ float bf_hi(unsigned u) { return __builtin_bit_cast(float, u & 0xffff0000u); }
__device__ __forceinline__ float wave_sum(float v) {
#pragma unroll
    for (int o = 1; o < 64; o <<= 1) v += __shfl_xor(v, o);
    return v;
}
__device__ __forceinline__ unsigned ld_u32_agent(const unsigned* p) { return __hip_atomic_load(p, RLX_AGENT); }

#define XB_TMO      128
#define XB_XCNT(j)  (256  + 64 * (j))
#define XB_XSUB(j)  (1280 + 64 * (j))
#define XB_XGEN(j)  (2304 + 64 * (j))
#define XB_TOP      3328
#define XB_TOPGEN   3392
#define XCD_BAR_WORDS 3456
#define XB_SPIN_CAP (1u << 18)
__device__ __forceinline__ unsigned xb_ld(unsigned* p)              { return __hip_atomic_load(p, __ATOMIC_RELAXED, __HIP_MEMORY_SCOPE_AGENT); }
__device__ __forceinline__ unsigned xb_add(unsigned* p, unsigned v) { return __hip_atomic_fetch_add(p, v, __ATOMIC_RELAXED, __HIP_MEMORY_SCOPE_AGENT); }
__device__ __forceinline__ unsigned xb_xcc_id() { return (unsigned)__builtin_amdgcn_s_getreg((3 << 11) | 20) & 0xFu; }
#define XB_SPIN(cond, bar) do { unsigned _sp = 0; while (cond) { __builtin_amdgcn_s_sleep(1); \
    if ((++_sp & 255u) == 0u) { if (xb_ld(&(bar)[XB_TMO])) break; if (_sp > XB_SPIN_CAP) { atomicAdd(&(bar)[XB_TMO], 1u); break; } } } } while (0)
struct XcdBarrier { unsigned* bar; unsigned x; volatile LAS unsigned* st; unsigned total; };
__device__ __forceinline__ XcdBarrier xcd_barrier_post(unsigned* bar, volatile LAS unsigned* st, unsigned total) {
    XcdBarrier b; b.bar = bar; b.x = xb_xcc_id(); b.st = st; b.total = total;
    if (threadIdx.x == 0) (void)xb_add(&bar[XB_XCNT(b.x)], 1u);
    return b;
}
__device__ __forceinline__ void xcd_barrier_complete(unsigned* bar, unsigned x, const unsigned G, unsigned& nloc, unsigned& nx) {
    unsigned sum, cnt, mine, sp = 0u;
    for (;;) {
        sum = 0u; cnt = 0u; mine = 0u;
#pragma unroll
        for (unsigned j = 0; j < 16; ++j) { const unsigned c = xb_ld(&bar[XB_XCNT(j)]); sum += c; cnt += (c > 0u) ? 1u : 0u; mine = (j == x) ? c : mine; }
        if (sum == G) break;
        __builtin_amdgcn_s_sleep(1);
        if ((++sp & 255u) == 0u) { if (xb_ld(&bar[XB_TMO])) break; if (sp > XB_SPIN_CAP) { atomicAdd(&bar[XB_TMO], 1u); break; } }
    }
    nloc = mine > 0u ? mine : 1u; nx = cnt > 0u ? cnt : 1u;
}
__device__ __forceinline__ void xcd_barrier(const XcdBarrier& b) {
    asm volatile("s_waitcnt vmcnt(0)" ::: "memory");
    __syncthreads();
    if (threadIdx.x == 0) {
        unsigned* bar = b.bar;
        __builtin_amdgcn_s_waitcnt(0);
        unsigned nloc = b.st[0], nx = b.st[1];
        if (nloc == 0u) { xcd_barrier_complete(bar, b.x, b.total, nloc, nx); b.st[0] = nloc; b.st[1] = nx; }
        const unsigned old = xb_add(&bar[XB_XSUB(b.x)], 1u);
        const unsigned gen = old / nloc;
        if (old + 1u == (gen + 1u) * nloc) {
            __builtin_amdgcn_fence(__ATOMIC_RELEASE, "agent");
            asm volatile("s_waitcnt vmcnt(0)" ::: "memory");
            const unsigned og = xb_add(&bar[XB_TOP], 1u);
            const unsigned tg = og / nx;
            if (og + 1u == (tg + 1u) * nx) xb_add(&bar[XB_TOPGEN], 1u);
            else XB_SPIN(xb_ld(&bar[XB_TOPGEN]) == tg, bar);
            __builtin_amdgcn_fence(__ATOMIC_ACQUIRE, "agent");
            xb_add(&bar[XB_XGEN(b.x)], 1u);
            asm volatile("s_waitcnt vmcnt(0)" ::: "memory");
        } else {
            XB_SPIN(xb_ld(&bar[XB_XGEN(b.x)]) == gen, bar);
            __builtin_amdgcn_fence(__ATOMIC_ACQUIRE, "agent");
            asm volatile("s_waitcnt vmcnt(0)" ::: "memory");
        }
    }
    __syncthreads();
}

constexpr int BM = 256, BK = 64, HALF = 128, HTB = HALF * BK * 2, NXCD = 8, WGM = 8;
__device__ __forceinline__ int lds_byte(int r, int c) { const int st = (r >> 4) * 2 + (c >> 5), rr = r & 15, cc = c & 31, ob = rr * 64 + cc * 2; return st * 1024 + (ob ^ (((ob >> 9) & 1) << 5)); }
__device__ __forceinline__ void stage_rc(int b, int& R, int& C) { const int st = b / 1024, sb = b % 1024, swz = sb ^ (((sb >> 9) & 1) << 5); R = (st >> 1) * 16 + swz / 64; C = (st & 1) * 32 + (swz % 64) / 2; }
__device__ __forceinline__ int perm32(int rho) { const int n = rho >> 4, i = rho & 15; return 8 * (i >> 2) + 4 * n + (i & 3); }

struct Unit { const char* a; const char* b; int pm, pn, e; };

struct DenseOrder {
    const char* A; const char* B; int nM, nN, nwg, G, c;
    __device__ void init(const void* A_, const void* B_, int M, int N, int G_, int c_) { A = (const char*)A_; B = (const char*)B_; nM = M / BM; nN = N / BM; nwg = nM * nN; G = G_; c = c_; }
    __device__ __forceinline__ bool next(int i, Unit& u) const {
        const long L = (long)i * G + c; if (L >= nwg) return false;
        int wgid = (int)L; { const int q = nwg / NXCD, r = nwg % NXCD, xcd = wgid % NXCD, off = wgid / NXCD; wgid = (xcd < r ? xcd * (q + 1) : r * (q + 1) + (xcd - r) * q) + off; }
        const int nig = WGM * nN, gid = wgid / nig, fm = gid * WGM, gsz = (nM - fm) < WGM ? (nM - fm) : WGM;
        u.pm = fm + ((wgid % nig) % gsz); u.pn = (wgid % nig) / gsz; u.e = 0;
        u.a = A + (size_t)u.pm * (size_t)(BM * KD * 2); u.b = B + (size_t)u.pn * (size_t)(BM * KD * 2); return true;
    }
};
template <int NT, int BROWS  > struct MoeOrder {
    const char* A; const char* B; const LAS int* mte; int nmt, G, c;
    __device__ __forceinline__ bool next(int i, Unit& u) const {
        const int U = nmt * NT;
        int j;
        if ((G & 7) == 0) { const int q = (U + 7) >> 3, Wx = G >> 3, jl = i * Wx + (c >> 3); if (jl >= q) return false; j = (c & 7) * q + jl; }
        else j = i * G + c;
        if (j >= U) return false;
        const int e = __builtin_amdgcn_readfirstlane(mte[j / NT]);
        const int es = __builtin_amdgcn_readfirstlane(mte[MOE_EST + e]), ec = __builtin_amdgcn_readfirstlane(mte[MOE_ECN + e]);
        const int idx = j - es * NT, nt = idx / ec, mt = es + idx % ec;
        u.pm = mt; u.pn = nt; u.e = e;
        u.a = A + (size_t)mt * (size_t)(BM * KD); u.b = B + ((size_t)e * 2048 + (size_t)nt * BROWS) * (size_t)KD; return true;
    }
};

template <class Epi, class Sched, bool FP8>
__device__ __forceinline__ void gemm_phase(LAS unsigned char* lds, const Sched& S, const Epi& E, const size_t bhstep) {
    const int tid = threadIdx.x, wid = __builtin_amdgcn_readfirstlane(tid >> 6), lane = tid & 63, wr = wid >> 2, wc = wid & 3, fr = lane & 15, fq = lane >> 4;
    constexpr int KROWB = FP8 ? KD : KD * 2, nt = KROWB / 128;
    unsigned voffA[2], voffB[2];
#pragma unroll
    for (int i = 0; i < 2; ++i) { int R, C; stage_rc(tid * 16 + i * 8192, R, C); const int Rb = Epi::PERM ? ((R & ~31) + perm32(R & 31)) : R;
        voffA[i] = (unsigned)(R * KROWB + C * 2); voffB[i] = (unsigned)(Rb * KROWB + C * 2); }
    const size_t kstep = (size_t)(BK * 2);
    const size_t hstep = (size_t)HALF * KROWB;
    const unsigned ldsw = (unsigned)wid * 1024u;
    const int aoff = lds_byte(wr * 64 + fr, fq * 8), boff = lds_byte(wc * 32 + fr, fq * 8);
#define PG8_SA(b, h) (((b) * 2 + (h)) * HTB)
#define PG8_SB(b, h) ((4 + (b) * 2 + (h)) * HTB)
#define PG8_STAGE(bufoff, gbase, voff) do { _Pragma("unroll") for (int _i = 0; _i < 2; ++_i) \
        __builtin_amdgcn_global_load_lds((const GAS unsigned*)((const GAS char*)(gbase) + (voff)[_i]), (LAS unsigned*)(lds + (bufoff) + ldsw + _i * 8192), 16, 0, 0); } while (0)
#define PG8_LDA(dst, b, h) do { _Pragma("unroll") for (int m = 0; m < 4; ++m) { const i32x4 lo_ = *(const LAS i32x4*)(lds + PG8_SA(b, h) + aoff + m * 2048), hi_ = *(const LAS i32x4*)(lds + PG8_SA(b, h) + aoff + m * 2048 + 1024); \
        dst[m] = __builtin_shufflevector(lo_, hi_, 0, 1, 2, 3, 4, 5, 6, 7); } } while (0)
#define PG8_LDB(dst, b, h) do { _Pragma("unroll") for (int n = 0; n < 2; ++n) { const i32x4 lo_ = *(const LAS i32x4*)(lds + PG8_SB(b, h) + boff + n * 2048), hi_ = *(const LAS i32x4*)(lds + PG8_SB(b, h) + boff + n * 2048 + 1024); \
        dst[n] = __builtin_shufflevector(lo_, hi_, 0, 1, 2, 3, 4, 5, 6, 7); } } while (0)
#define PG8_MMA(ai, bj, At, Bt) do { __builtin_amdgcn_s_setprio(1); _Pragma("unroll") for (int m = 0; m < 4; ++m) _Pragma("unroll") for (int n = 0; n < 2; ++n) { \
        if constexpr (FP8) { asm volatile("v_mfma_scale_f32_16x16x128_f8f6f4 %0, %1, %2, %0, %3, %3 op_sel_hi:[0,0,0]" : "+v"(acc[ai][bj][m][n]) : "v"(Bt[n]), "v"(At[m]), "v"(mxscale)); } \
        else { acc[ai][bj][m][n] = __builtin_amdgcn_mfma_f32_16x16x32_bf16(__builtin_bit_cast(bf16x8, __builtin_shufflevector(Bt[n], Bt[n], 0, 1, 2, 3)), __builtin_bit_cast(bf16x8, __builtin_shufflevector(At[m], At[m], 0, 1, 2, 3)), acc[ai][bj][m][n], 0, 0, 0); \
               acc[ai][bj][m][n] = __builtin_amdgcn_mfma_f32_16x16x32_bf16(__builtin_bit_cast(bf16x8, __builtin_shufflevector(Bt[n], Bt[n], 4, 5, 6, 7)), __builtin_bit_cast(bf16x8, __builtin_shufflevector(At[m], At[m], 4, 5, 6, 7)), acc[ai][bj][m][n], 0, 0, 0); } } \
        __builtin_amdgcn_s_setprio(0); } while (0)
#define PG8_WAIT_V(n) asm volatile("s_waitcnt vmcnt(" #n ")" ::: "memory")
#define PG8_WAIT_L(n) asm volatile("s_waitcnt lgkmcnt(" #n ")" ::: "memory")
#define PG8_BAR __builtin_amdgcn_s_barrier()
#define PG8_SCHED __builtin_amdgcn_sched_barrier(0)
    Unit cur, nxt; int ui = 0;
    if (!S.next(0, cur)) return;
    f32x4 acc[2][2][4][2];
#pragma unroll
    for (int a = 0; a < 2; ++a)
#pragma unroll
        for (int b = 0; b < 2; ++b)
#pragma unroll
            for (int m = 0; m < 4; ++m)
#pragma unroll
                for (int n = 0; n < 2; ++n) acc[a][b][m][n] = (f32x4){0.f, 0.f, 0.f, 0.f};
    i32x8 At[4], B0[2], B1[2];
    int mxscale = 0x7F7F7F7F; asm volatile("" : "+v"(mxscale));
    const char* cA = cur.a; const char* cB = cur.b;
    PG8_STAGE(PG8_SB(0, 0), cB, voffB); PG8_STAGE(PG8_SB(0, 1), cB + bhstep, voffB); PG8_STAGE(PG8_SA(0, 0), cA, voffA); PG8_STAGE(PG8_SA(0, 1), cA + hstep, voffA);
    if (wr == 1) PG8_BAR;
    PG8_WAIT_V(2); PG8_BAR;
    PG8_STAGE(PG8_SB(1, 0), cB + kstep, voffB); PG8_STAGE(PG8_SA(1, 0), cA + kstep, voffA); PG8_STAGE(PG8_SB(1, 1), cB + bhstep + kstep, voffB);
    PG8_WAIT_V(6); PG8_BAR;
    for (;;) {
        const bool has_next = S.next(ui + 1, nxt);
        const char* nA = has_next ? nxt.a : cA; const char* nB = has_next ? nxt.b : cB;
        for (int t = 0; t < nt; t += 2) {
            const bool last = (t == nt - 2);
            const char* a1 = cA + (size_t)(t + 1) * kstep;
            const char* a2 = last ? nA : cA + (size_t)(t + 2) * kstep; const char* b2 = last ? nB : cB + (size_t)(t + 2) * kstep;
            const char* a3 = a2 + kstep; const char* b3 = b2 + kstep;
            PG8_LDB(B0, 0, 0); PG8_LDB(B1, 0, 1); PG8_SCHED; PG8_LDA(At, 0, 0); PG8_STAGE(PG8_SA(1, 1), a1 + hstep, voffA);
            PG8_WAIT_V(8); PG8_WAIT_L(0); PG8_BAR; PG8_MMA(0, 0, At, B0); PG8_MMA(0, 1, At, B1); PG8_BAR; PG8_SCHED;
            PG8_LDA(At, 0, 1); PG8_STAGE(PG8_SB(0, 0), b2, voffB); PG8_STAGE(PG8_SB(0, 1), b2 + bhstep, voffB); PG8_STAGE(PG8_SA(0, 0), a2, voffA);
            PG8_WAIT_V(8); PG8_WAIT_L(0); PG8_BAR; PG8_MMA(1, 0, At, B0); PG8_MMA(1, 1, At, B1); PG8_BAR; PG8_SCHED;
            PG8_LDB(B0, 1, 0); PG8_LDB(B1, 1, 1); PG8_SCHED; PG8_LDA(At, 1, 0); PG8_STAGE(PG8_SA(0, 1), a2 + hstep, voffA);
            PG8_WAIT_V(8); PG8_WAIT_L(0); PG8_BAR; PG8_MMA(0, 0, At, B0); PG8_MMA(0, 1, At, B1); PG8_BAR; PG8_SCHED;
            PG8_LDA(At, 1, 1); PG8_STAGE(PG8_SB(1, 0), b3, voffB); PG8_STAGE(PG8_SB(1, 1), b3 + bhstep, voffB); PG8_STAGE(PG8_SA(1, 0), a3, voffA);
            PG8_WAIT_V(8); PG8_WAIT_L(0); PG8_BAR; PG8_MMA(1, 0, At, B0); PG8_MMA(1, 1, At, B1); PG8_BAR; PG8_SCHED;
        }
        if (wr == 0) PG8_BAR;
        if constexpr (FP8) { asm volatile("s_nop 15\n\ts_nop 15" ::: "memory"); }
        E(acc, cur, wr, wc, fr, fq);
        if (!has_next) break;
#pragma unroll
        for (int a = 0; a < 2; ++a)
#pragma unroll
            for (int b = 0; b < 2; ++b)
#pragma unroll
                for (int m = 0; m < 4; ++m)
#pragma unroll
                    for (int n = 0; n < 2; ++n) acc[a][b][m][n] = (f32x4){0.f, 0.f, 0.f, 0.f};
        cur = nxt; cA = nA; cB = nB; ++ui;
        if (wr == 1) PG8_BAR;
    }
    PG8_WAIT_V(0);
    PG8_BAR;
#undef PG8_SA
#undef PG8_SB
#undef PG8_STAGE
#undef PG8_LDA
#undef PG8_LDB
#undef PG8_MMA
#undef PG8_WAIT_V
#undef PG8_WAIT_L
#undef PG8_BAR
#undef PG8_SCHED
}

struct EpiInProj {
    static constexpr bool PERM = true;
    bf16_t* P; const float* cs; const float* sn;
    __device__ __forceinline__ void operator()(const f32x4 (&acc)[2][2][4][2], const Unit& u, int wr, int wc, int fr, int fq) const {
        const int row0 = u.pm * BM + wr * 64 + fr, colt = u.pn * BM, i0 = wc * 32 + 8 * fq;
        const bool rot = u.pn < 8; const float ksc = (u.pn >= 4 && u.pn < 8) ? 0.0625f : 1.f;
#pragma unroll
        for (int ai = 0; ai < 2; ++ai)
#pragma unroll
            for (int m = 0; m < 4; ++m) {
                const int row = row0 + ai * HALF + m * 16;
                f32x4 a0 = acc[ai][0][m][0], a1 = acc[ai][0][m][1], b0 = acc[ai][1][m][0], b1 = acc[ai][1][m][1];
                if (rot) {
                    const f32x4 c0 = *(const f32x4*)(cs + (size_t)row * 128 + i0), c1 = *(const f32x4*)(cs + (size_t)row * 128 + i0 + 4);
                    const f32x4 s0 = *(const f32x4*)(sn + (size_t)row * 128 + i0), s1 = *(const f32x4*)(sn + (size_t)row * 128 + i0 + 4);
                    const f32x4 o0 = (a0 * c0 - b0 * s0) * ksc, o1 = (a1 * c1 - b1 * s1) * ksc, p0 = (a0 * s0 + b0 * c0) * ksc, p1 = (a1 * s1 + b1 * c1) * ksc;
                    a0 = o0; a1 = o1; b0 = p0; b1 = p1;
                }
                bf16_t* rp = P + (size_t)row * INC + colt + i0;
                *(u32x4*)rp = (u32x4){cvt_pk_bf16(a0[0], a0[1]), cvt_pk_bf16(a0[2], a0[3]), cvt_pk_bf16(a1[0], a1[1]), cvt_pk_bf16(a1[2], a1[3])};
                *(u32x4*)(rp + HALF) = (u32x4){cvt_pk_bf16(b0[0], b0[1]), cvt_pk_bf16(b0[2], b0[3]), cvt_pk_bf16(b1[0], b1[1]), cvt_pk_bf16(b1[2], b1[3])};
            }
    }
};
struct EpiOutProj {
    static constexpr bool PERM = true;
    const float* X; bf16_t* H;
    __device__ __forceinline__ void operator()(const f32x4 (&acc)[2][2][4][2], const Unit& u, int wr, int wc, int fr, int fq) const {
        const int row0 = u.pm * BM + wr * 64 + fr, col0 = u.pn * BM + wc * 32 + 8 * fq;
#pragma unroll
        for (int ai = 0; ai < 2; ++ai)
#pragma unroll
            for (int m = 0; m < 4; ++m) {
                const size_t ro = (size_t)(row0 + ai * HALF + m * 16) * DM + col0;
#pragma unroll
                for (int bj = 0; bj < 2; ++bj) {
                    const f32x4 x0 = __builtin_nontemporal_load((const f32x4*)(X + ro + bj * HALF)), x1 = __builtin_nontemporal_load((const f32x4*)(X + ro + bj * HALF + 4));
                    const f32x4 h0 = acc[ai][bj][m][0] + x0, h1 = acc[ai][bj][m][1] + x1;
                    *(u32x4*)(H + ro + bj * HALF) = (u32x4){cvt_pk_bf16(h0[0], h0[1]), cvt_pk_bf16(h0[2], h0[3]), cvt_pk_bf16(h1[0], h1[1]), cvt_pk_bf16(h1[2], h1[3])};
                }
            }
    }
};
__device__ __forceinline__ float swiglu1(float g, float u) {
    g = fminf(g, 7.0f); u = fminf(fmaxf(u, -7.0f), 7.0f);
    const float sg = __builtin_amdgcn_rcpf(1.0f + __builtin_amdgcn_exp2f(-1.702f * 1.4426950408889634f * g));
    return (u + 1.0f) * g * sg;
}
__device__ __forceinline__ void store_pair16(unsigned char* base, size_t row_a, size_t row_b, int col_even, bool odd, u32x2 da, u32x2 db) {
    const unsigned s0 = odd ? da.x : db.x, s1 = odd ? da.y : db.y;
    const unsigned r0 = (unsigned)__shfl_xor((int)s0, 16), r1 = (unsigned)__shfl_xor((int)s1, 16);
    const u32x4 o = odd ? (u32x4){r0, r1, db.x, db.y} : (u32x4){da.x, da.y, r0, r1};
    *(u32x4*)(base + (odd ? row_b : row_a) * 2048 + col_even) = o;
}
struct EpiGateUp {
    static constexpr bool PERM = true;
    unsigned char* Hd; const float* bg; const float* bu;
    __device__ __forceinline__ void operator()(const f32x4 (&acc)[2][2][4][2], const Unit& u, int wr, int wc, int fr, int fq) const {
        const int row0 = u.pm * BM + wr * 64 + fr, colh = u.pn * HALF + wc * 32 + 8 * fq, col_even = u.pn * HALF + wc * 32 + 8 * (fq & ~1);
        const bool odd = fq & 1;
        const f32x4 g0 = *(const f32x4*)(bg + (size_t)u.e * 2048 + colh), g1 = *(const f32x4*)(bg + (size_t)u.e * 2048 + colh + 4);
        const f32x4 u0 = *(const f32x4*)(bu + (size_t)u.e * 2048 + colh), u1 = *(const f32x4*)(bu + (size_t)u.e * 2048 + colh + 4);
#pragma unroll
        for (int ai = 0; ai < 2; ++ai)
#pragma unroll
            for (int m = 0; m < 4; m += 2) {
                u32x2 d[2];
#pragma unroll
                for (int mm = 0; mm < 2; ++mm) {
                    const f32x4 ga = acc[ai][0][m + mm][0] * 0.015625f + g0, gb = acc[ai][0][m + mm][1] * 0.015625f + g1, ua = acc[ai][1][m + mm][0] * 0.015625f + u0, ub = acc[ai][1][m + mm][1] * 0.015625f + u1;
                    float h[8];
#pragma unroll
                    for (int j = 0; j < 4; ++j) { h[j] = swiglu1(ga[j], ua[j]); h[4 + j] = swiglu1(gb[j], ub[j]); }
                    d[mm] = (u32x2){cvt_pk4_fp8(h[0], h[1], h[2], h[3]), cvt_pk4_fp8(h[4], h[5], h[6], h[7])};
                }
                const size_t ra = (size_t)(row0 + ai * HALF + m * 16), rb = ra + 16;
                store_pair16(Hd, ra, rb, col_even, odd, d[0], d[1]);
            }
    }
};
struct EpiDown {
    static constexpr bool PERM = true;
    unsigned char* Y; const float* bd; const float* sw;
    __device__ __forceinline__ void operator()(const f32x4 (&acc)[2][2][4][2], const Unit& u, int wr, int wc, int fr, int fq) const {
        const int row0 = u.pm * BM + wr * 64 + fr, col0 = u.pn * BM + wc * 32 + 8 * fq, col_even = u.pn * BM + wc * 32 + 8 * (fq & ~1);
        const bool odd = fq & 1;
        f32x4 bv[2][2];
#pragma unroll
        for (int bj = 0; bj < 2; ++bj)
#pragma unroll
            for (int n = 0; n < 2; ++n) bv[bj][n] = *(const f32x4*)(bd + (size_t)u.e * 2048 + col0 + bj * HALF + 4 * n);
#pragma unroll
        for (int ai = 0; ai < 2; ++ai)
#pragma unroll
            for (int m = 0; m < 4; m += 2) {
                const int ra = row0 + ai * HALF + m * 16, rb = ra + 16;
                const float wa = sw[ra] * 16.f, wb = sw[rb] * 16.f;
#pragma unroll
                for (int bj = 0; bj < 2; ++bj) {
                    const f32x4 a0 = (acc[ai][bj][m][0] * 0.015625f + bv[bj][0]) * wa, a1 = (acc[ai][bj][m][1] * 0.015625f + bv[bj][1]) * wa;
                    const f32x4 b0 = (acc[ai][bj][m + 1][0] * 0.015625f + bv[bj][0]) * wb, b1 = (acc[ai][bj][m + 1][1] * 0.015625f + bv[bj][1]) * wb;
                    const u32x2 da = (u32x2){cvt_pk4_fp8(a0[0], a0[1], a0[2], a0[3]), cvt_pk4_fp8(a1[0], a1[1], a1[2], a1[3])};
                    const u32x2 db = (u32x2){cvt_pk4_fp8(b0[0], b0[1], b0[2], b0[3]), cvt_pk4_fp8(b1[0], b1[1], b1[2], b1[3])};
                    store_pair16(Y, (size_t)ra, (size_t)rb, col_even + bj * HALF, odd, da, db);
                }
            }
    }
};

struct Args { const float* in[16]; float* out; unsigned char* ws; int ph_lo, ph_hi; };
enum { I_X = 0, I_POS, I_G1, I_WIN, I_WOUT, I_RELB, I_G2, I_RW, I_RB, I_WG, I_BG, I_WU, I_BU, I_WD, I_BD, I_GF };

__device__ __forceinline__ void p0_transpose_item(const float* W, int N, bf16_t* WT, int kb, int nb, LAS unsigned* scr, int lane) {
    const int k0 = 128 * kb, n0 = 64 * nb, kq = lane >> 4, nq = lane & 15;
    f32x4 v[32];
#pragma unroll
    for (int i = 0; i < 32; ++i) { const int half = i >> 4, ii = i & 15; const int k = half * 64 + 2 * (kq + 4 * (ii >> 1)) + (ii & 1);
        v[i] = __builtin_nontemporal_load((const f32x4*)(W + (size_t)(k0 + k) * N + n0 + 4 * nq)); }
#pragma unroll
    for (int half = 0; half < 2; ++half)
#pragma unroll
        for (int a = 0; a < 8; ++a)
#pragma unroll
            for (int j = 0; j < 4; ++j) scr[(4 * nq + j) * 68 + half * 32 + kq + 4 * a] = cvt_pk_bf16(v[half * 16 + 2 * a][j], v[half * 16 + 2 * a + 1][j]);
    LDS_WAIT();
#pragma unroll
    for (int r = 0; r < 16; ++r) { const int n = 4 * r + kq; const u32x4 o = *(const LAS u32x4*)(scr + n * 68 + nq * 4); __builtin_nontemporal_store(o, (u32x4*)(WT + (size_t)(n0 + n) * KD + k0 + 8 * nq)); }
    LDS_WAIT();
}
__device__ __forceinline__ void p0_transpose_item_fp8(const float* W, unsigned char* WT, int kb, int nb, LAS unsigned* scr, int lane) {
    const int k0 = 256 * kb, n0 = 64 * nb, kq = lane >> 4, nq = lane & 15;
#pragma unroll
    for (int pass = 0; pass < 2; ++pass) {
        f32x4 v[32];
#pragma unroll
        for (int i = 0; i < 32; ++i) { const int q = i >> 4, a = (i >> 2) & 3, t = i & 3; const int k = pass * 128 + q * 64 + 4 * (kq + 4 * a) + t;
            v[i] = __builtin_nontemporal_load((const f32x4*)(W + (size_t)(k0 + k) * 2048 + n0 + 4 * nq)); }
#pragma unroll
        for (int q = 0; q < 2; ++q)
#pragma unroll
            for (int a = 0; a < 4; ++a)
#pragma unroll
                for (int j = 0; j < 4; ++j) { const int b = q * 16 + 4 * a;
                    scr[(4 * nq + j) * 68 + pass * 32 + q * 16 + kq + 4 * a] = cvt_pk4_fp8(v[b][j] * 64.f, v[b + 1][j] * 64.f, v[b + 2][j] * 64.f, v[b + 3][j] * 64.f); }
    }
    LDS_WAIT();
#pragma unroll
    for (int r = 0; r < 16; ++r) { const int n = 4 * r + kq; const u32x4 o = *(const LAS u32x4*)(scr + n * 68 + nq * 4); __builtin_nontemporal_store(o, (u32x4*)(WT + (size_t)(n0 + n) * 2048 + k0 + 16 * nq)); }
    LDS_WAIT();
}
__device__ __forceinline__ void sincos_d(double x, float& c, float& s) {
    const double TWO_OVER_PI = 0.63661977236758134308, P1 = 1.57079632673412561417e+00, P2 = 6.07710050650619224932e-11;
    const double fn = __builtin_rint(x * TWO_OVER_PI);
    double r = __builtin_fma(-fn, P1, x); r = __builtin_fma(-fn, P2, r);
    const int q = (int)((long long)fn & 3);
    const double z = r * r;
    double ps = -7.6471637318198164759e-13; ps = ps * z + 1.6059043836821614599e-10; ps = ps * z - 2.5052108385441718775e-08; ps = ps * z + 2.7557319223985890653e-06;
    ps = ps * z - 1.9841269841269841270e-04; ps = ps * z + 8.3333333333333333333e-03; ps = ps * z - 1.6666666666666666667e-01;
    const double sv = r + r * z * ps;
    double pc = 4.7794773323873852974e-14; pc = pc * z - 1.1470745597729724714e-11; pc = pc * z + 2.0876756987868098979e-09; pc = pc * z - 2.7557319223985890653e-07;
    pc = pc * z + 2.4801587301587301587e-05; pc = pc * z - 1.3888888888888888889e-03; pc = pc * z + 4.1666666666666666667e-02; pc = pc * z - 0.5;
    const double cv = 1.0 + z * pc;
    const double cc = (q == 0) ? cv : (q == 1) ? -sv : (q == 2) ? -cv : sv;
    const double ss = (q == 0) ? sv : (q == 1) ? cv : (q == 2) ? -sv : -cv;
    c = (float)cc; s = (float)ss;
}
__device__ __forceinline__ void p0_prologue(const Args& A, LAS unsigned char* lds, int wave, int lane, int vcu, int G) {
    unsigned char* ws = A.ws;
    LAS unsigned* scr = (LAS unsigned*)(lds + wave * 17408);
    const int gw = vcu * 8 + wave, NGW = G * 8;
    constexpr int I_IN = 16 * (INC / 64), I_OUT = 16 * 32;
    constexpr int NITEMS = I_IN + I_OUT;
    for (int it = gw; it < NITEMS; it += NGW) {
        int r = it;
        if (r < I_IN) { p0_transpose_item(A.in[I_WIN], INC, (bf16_t*)(ws + WS_WIN), r / (INC / 64), r % (INC / 64), scr, lane); continue; } r -= I_IN;
        p0_transpose_item(A.in[I_WOUT], DM, (bf16_t*)(ws + WS_WOUT), r / 32, r % 32, scr, lane);
    }
    const float* x = A.in[I_X]; const float* g1 = A.in[I_G1]; bf16_t* XN = (bf16_t*)(ws + WS_XN);
    for (int m = gw; m < NTOK; m += NGW) {
        const f32x4* xr = (const f32x4*)(x + (size_t)m * DM) + lane;
        f32x4 v[8]; float s = 0.f;
#pragma unroll
        for (int j = 0; j < 8; ++j) { v[j] = xr[64 * j]; s += (v[j].x * v[j].x + v[j].y * v[j].y) + (v[j].z * v[j].z + v[j].w * v[j].w); }
        const float rstd = 1.0f / sqrtf(wave_sum(s) * (1.f / DM) + NORM_EPS);
        u32x2* o8 = (u32x2*)(XN + (size_t)m * DM) + lane;
#pragma unroll
        for (int j = 0; j < 8; ++j) { const f32x4 g = ((const f32x4*)g1)[lane + 64 * j]; const f32x4 y = v[j] * rstd * g; o8[64 * j] = (u32x2){cvt_pk_bf16(y.x, y.y), cvt_pk_bf16(y.z, y.w)}; }
    }
    const int* pos = (const int*)A.in[I_POS]; float* CS = (float*)(ws + WS_COS); float* SN = (float*)(ws + WS_SIN);
    for (int idx = (vcu * 512 + (int)threadIdx.x); idx < NTOK * 128; idx += G * 512) {
        const int m = idx >> 7, i = idx & 127;
        const float pw = (float)exp2((double)i * (13.287712379549449 / 128.0));
        const float invf = 1.0f / pw;
        const float ang = (float)pos[m] * invf;
        float c, s; sincos_d((double)ang, c, s);
        CS[idx] = c; SN[idx] = s;
    }
    { const float* g2 = A.in[I_G2]; const float* RW = A.in[I_RW]; bf16_t* RWT = (bf16_t*)(ws + WS_RT + RT_RWT);
      for (int idx = (vcu * 512 + (int)threadIdx.x); idx < 32 * 2048; idx += G * 512) {
          const int j = idx >> 11, k = idx & 2047;
          const float v = g2[k] * RW[(size_t)k * 32 + j];
          const unsigned hi = cvt_pk_bf16(v, 0.f) & 0xffffu; const float lo = v - bf_lo(hi);
          RWT[idx] = (bf16_t)hi; RWT[32 * 2048 + idx] = (bf16_t)(cvt_pk_bf16(lo, 0.f) & 0xffffu);
      } }
}

constexpr int CONV_GU_ITEMS = 64 * 256, CONV_D_ITEMS = 32 * 256, CONV_CLAIM = 8, CONV_RESERVE = 1024;
template <bool DOWN>
__device__ __forceinline__ void conv_drain(const Args& A, LAS unsigned char* lds, int wave, int lane, unsigned* qctr, const int base, const int count) {
    unsigned char* ws = A.ws;
    volatile LAS unsigned* cq = (volatile LAS unsigned*)(lds + CTL_OFF + 128);
    LAS unsigned* scr = (LAS unsigned*)(lds + wave * 17408);
    constexpr int NIT = DOWN ? CONV_D_ITEMS : CONV_GU_ITEMS;
    for (;;) {
        if (threadIdx.x == 0) cq[0] = __hip_atomic_fetch_add(qctr, (unsigned)CONV_CLAIM, RLX_AGENT);
        __syncthreads();
        const unsigned start = cq[0];
        __syncthreads();
        if (start >= (unsigned)count) break;
#pragma unroll 1
        for (int j = 0; j < CONV_CLAIM / 8; ++j) {
            const int r = base + (int)start + j * 8 + wave;
            if (r < base + count) {
                const int mat = r >> 8, rr = r & 255, e = DOWN ? mat : (mat >> 1);
                const float* src = (DOWN ? A.in[I_WD] : (mat & 1) ? A.in[I_WU] : A.in[I_WG]) + (size_t)e * 2048 * 2048;
                unsigned char* dst = ws + (DOWN ? WS_WD : (mat & 1) ? WS_WU : WS_WG) + (size_t)e * 2048 * 2048;
                p0_transpose_item_fp8(src, dst, rr >> 5, rr & 31, scr, lane);
            }
        }
    }
}

__device__ __forceinline__ unsigned lds_addr(const volatile LAS void* p) { return (unsigned)(size_t)p; }
__device__ __forceinline__ void glds16_asm(const void* gsrc, unsigned lds_dst) {
    unsigned keep;
    asm volatile("s_mov_b32 %0, m0\n\ts_mov_b32 m0, %2\n\ts_nop 0\n\tglobal_load_lds_dwordx4 %1, off\n\ts_mov_b32 m0, %0" : "=&s"(keep) : "v"(gsrc), "s"(lds_dst) : "memory");
}
template <int D> struct BandCfg { static constexpr int ROWB = D * 2, TILEB = 64 * ROWB, STAGEB = 2 * TILEB, NS = D / 32, NDT = D / 16, NPW = (TILEB / 1024) / 8  , RPI = 1024 / ROWB  ; };

__device__ constexpr double kLog2Gamma[4] = { -0.04580368961312479, -0.018003552928331026, -0.007117849617096985, -0.0028205190623786626 };

template <int D, bool ATT>
__device__ __forceinline__ void band_unit(const Args& A, LAS unsigned char* lds, int b, int h, int cp, int wave, int lane) {
    typedef BandCfg<D> C;
    const bf16_t* PROJ = (const bf16_t*)(A.ws + WS_PROJ);
    bf16_t* MIX = (bf16_t*)(A.ws + WS_MIX);
    const int tid = threadIdx.x, qt = wave & 3, qc = wave >> 2, g4 = lane >> 4, li = lane & 15;
    const int qoff = ATT ? OFF_AQ + h * 128 : OFF_RQ + h * 256, koff = ATT ? OFF_AK + h * 128 : OFF_RK + h * 256, voff = ATT ? OFF_AV + h * 128 : OFF_RV + h * 256;
    const int cq = 2 * cp + qc;
    const int qrow = b * SEQ + cq * CH + 16 * qt + li, nq = 16 * qt + li;
    LAS float* btab = (LAS float*)(lds + TAB_OFF + 1024);
    if (ATT) { if (tid < 320) btab[tid] = A.in[I_RELB][h * 320 + tid] * 1.4426950408889634f; }
    unsigned srcK[C::NPW], srcV[C::NPW];
#pragma unroll
    for (int i = 0; i < C::NPW; ++i) {
        const int j = C::NPW * wave + i, row = C::RPI * j + lane / (C::ROWB / 16), pc = lane % (C::ROWB / 16);
        const int ck = (pc & 16) | ((pc ^ row) & 15), cv = (pc & 16) | ((pc ^ (2 * (row & 7))) & 15);
        srcK[i] = (unsigned)(row * (INC * 2) + koff * 2 + 16 * ck); srcV[i] = (unsigned)(row * (INC * 2) + voff * 2 + 16 * cv);
    }
#define BAND_DMA(kc_, st_) do { const char* gb_ = (const char*)PROJ + ((size_t)b * SEQ + (size_t)(kc_) * CH) * (size_t)(INC * 2); \
        const unsigned sb_ = __builtin_amdgcn_readfirstlane(lds_addr(lds + (st_) * C::STAGEB + C::NPW * wave * 1024)); \
        _Pragma("unroll") for (int i = 0; i < C::NPW; ++i) { glds16_asm(gb_ + srcK[i], sb_ + i * 1024); glds16_asm(gb_ + srcV[i], sb_ + C::TILEB + i * 1024); } } while (0)
    const int kc_hi = 2 * cp + 1, kc_lo = ATT ? (2 * cp > 8 ? 2 * cp - 8 : 0) : 0;
    BAND_DMA(kc_lo, 0);
    bf16x8 Qf[C::NS];
#pragma unroll
    for (int s = 0; s < C::NS; ++s) Qf[s] = *(const bf16x8*)(PROJ + (size_t)qrow * INC + qoff + 32 * s + 8 * g4);
#pragma unroll
    for (int s = 0; s < C::NS; ++s) asm volatile("" : "+v"(Qf[s]));
    f32x4 O[C::NDT];
#pragma unroll
    for (int d = 0; d < C::NDT; ++d) O[d] = (f32x4){0.f, 0.f, 0.f, 0.f};
    float mrun = -1e30f, lsum = 0.f;
    const float l2g = ATT ? 0.f : (float)kLog2Gamma[h];
    const int kbase = li * C::ROWB, kx = li;
    const int vr0 = 4 * g4 + (li >> 2), vbase = vr0 * C::ROWB + 8 * (li & 1), vx = 2 * (vr0 & 7), vp = (li & 3) >> 1;
    int st = 0;
    for (int kc = kc_lo; kc <= kc_hi; ++kc, st ^= 1) {
        asm volatile("s_waitcnt vmcnt(0)" ::: "memory");
        __builtin_amdgcn_s_barrier();
        asm volatile("" ::: "memory");
        if (kc < kc_hi) BAND_DMA(kc + 1, st ^ 1);
        const bool active = (kc <= cq) && (!ATT || kc >= cq - 8);
        if (active) {
        LAS unsigned char* KS = lds + st * C::STAGEB; LAS unsigned char* VS = KS + C::TILEB;
        f32x4 S[4];
#pragma unroll
        for (int t = 0; t < 4; ++t) S[t] = (f32x4){0.f, 0.f, 0.f, 0.f};
#define SCHED __builtin_amdgcn_sched_barrier(0)
#define LDK(dst, s_) do { const int ch_ = ((4 * (s_)) & 16) | (((4 * (s_) + g4) ^ kx) & 15); _Pragma("unroll") for (int t = 0; t < 4; ++t) dst[t] = *(const LAS bf16x8*)(KS + kbase + 16 * t * C::ROWB + 16 * ch_); } while (0)
        {
            bf16x8 kA[4], kB[4];
            LDK(kA, 0);
#pragma unroll
            for (int s = 0; s < C::NS; s += 2) {
                LDK(kB, s + 1); SCHED;
#pragma unroll
                for (int t = 0; t < 4; ++t) S[t] = __builtin_amdgcn_mfma_f32_16x16x32_bf16(kA[t], Qf[s], S[t], 0, 0, 0);
                SCHED;
                if (s + 2 < C::NS) LDK(kA, s + 2);
                SCHED;
#pragma unroll
                for (int t = 0; t < 4; ++t) S[t] = __builtin_amdgcn_mfma_f32_16x16x32_bf16(kB[t], Qf[s + 1], S[t], 0, 0, 0);
                SCHED;
            }
        }
#undef LDK
        const int rel0 = 64 * (cq - kc) + nq - 4 * g4;
        float p[16];
        if (ATT) {
            float sc[16];
#pragma unroll
            for (int t = 0; t < 4; ++t)
#pragma unroll
                for (int r = 0; r < 4; ++r) { int i0 = rel0 - 16 * t - r; i0 = (i0 > 256 ? 256 : i0) + 63; sc[4 * t + r] = S[t][r] * (0.08838834764831845f * 1.4426950408889634f) + btab[i0]; }
            float mx = sc[0];
#pragma unroll
            for (int r = 1; r < 16; ++r) mx = fmaxf(mx, sc[r]);
            mx = fmaxf(mx, __shfl_xor(mx, 16)); mx = fmaxf(mx, __shfl_xor(mx, 32));
            const float mnew = fmaxf(mrun, mx), alpha = __builtin_amdgcn_exp2f(mrun - mnew);
            float ps = 0.f;
#pragma unroll
            for (int r = 0; r < 16; ++r) { p[r] = __builtin_amdgcn_exp2f(sc[r] - mnew); ps += p[r]; }
            lsum = lsum * alpha + ps; mrun = mnew;
#pragma unroll
            for (int d = 0; d < C::NDT; ++d) O[d] = O[d] * alpha;
        } else {
#pragma unroll
            for (int t = 0; t < 4; ++t)
#pragma unroll
                for (int r = 0; r < 4; ++r) { int d0 = rel0 - 16 * t - r; d0 = d0 < 0 ? -d0 : d0; p[4 * t + r] = S[t][r] * __builtin_amdgcn_exp2f(l2g * (float)d0); }
        }
        bf16x8 Pf[2];
#pragma unroll
        for (int ks = 0; ks < 2; ++ks) { const u32x4 pk = (u32x4){cvt_pk_bf16(p[8 * ks], p[8 * ks + 1]), cvt_pk_bf16(p[8 * ks + 2], p[8 * ks + 3]), cvt_pk_bf16(p[8 * ks + 4], p[8 * ks + 5]), cvt_pk_bf16(p[8 * ks + 6], p[8 * ks + 7])}; Pf[ks] = __builtin_bit_cast(bf16x8, pk); }
#define LDV(dst, i_) do { _Pragma("unroll") for (int dd = 0; dd < 2; ++dd) { const int d_ = 2 * (i_) + dd; const int ch_ = ((2 * d_) & 16) | (((2 * d_ + vp) ^ vx) & 15); \
            _Pragma("unroll") for (int ks = 0; ks < 2; ++ks) { \
                const s16x4 lo_ = __builtin_amdgcn_ds_read_tr16_b64_v4i16((LAS s16x4*)(VS + vbase + 32 * ks * C::ROWB + 16 * ch_)); \
                const s16x4 hi_ = __builtin_amdgcn_ds_read_tr16_b64_v4i16((LAS s16x4*)(VS + vbase + (32 * ks + 16) * C::ROWB + 16 * ch_)); \
                dst[2 * dd + ks] = __builtin_shufflevector(lo_, hi_, 0, 1, 2, 3, 4, 5, 6, 7); } } } while (0)
#define PVMMA(src, i_) do { _Pragma("unroll") for (int dd = 0; dd < 2; ++dd) { O[2 * (i_) + dd] = __builtin_amdgcn_mfma_f32_16x16x32_bf16(src[2 * dd], Pf[0], O[2 * (i_) + dd], 0, 0, 0); \
            O[2 * (i_) + dd] = __builtin_amdgcn_mfma_f32_16x16x32_bf16(src[2 * dd + 1], Pf[1], O[2 * (i_) + dd], 0, 0, 0); } } while (0)
        {
            bf16x8 vA[4], vB[4];
            SCHED; LDV(vA, 0);
#pragma unroll
            for (int i = 0; i < C::NDT / 2; i += 2) {
                LDV(vB, i + 1); SCHED;
                PVMMA(vA, i); SCHED;
                if (i + 2 < C::NDT / 2) LDV(vA, i + 2);
                SCHED;
                PVMMA(vB, i + 1); SCHED;
            }
        }
#undef LDV
#undef PVMMA
#undef SCHED
        }
    }
    if (ATT) {
        lsum += __shfl_xor(lsum, 16); lsum += __shfl_xor(lsum, 32);
        const float linv = __builtin_amdgcn_rcpf(lsum);
        bf16_t* op = MIX + (size_t)qrow * DM + 1024 + h * 128 + 4 * g4;
#pragma unroll
        for (int d = 0; d < C::NDT; ++d) *(u32x2*)(op + 16 * d) = (u32x2){cvt_pk_bf16(O[d].x * linv, O[d].y * linv), cvt_pk_bf16(O[d].z * linv, O[d].w * linv)};
    } else {
        float ss = 0.f;
#pragma unroll
        for (int d = 0; d < C::NDT; ++d) ss += (O[d].x * O[d].x + O[d].y * O[d].y) + (O[d].z * O[d].z + O[d].w * O[d].w);
        ss += __shfl_xor(ss, 16); ss += __shfl_xor(ss, 32);
        const float rinv = 1.0f / sqrtf(ss * (1.f / 256.f) + NORM_EPS);
        const bf16_t* gp = PROJ + (size_t)qrow * INC + OFF_RG + h * 256 + 4 * g4;
        bf16_t* op = MIX + (size_t)qrow * DM + h * 256 + 4 * g4;
#pragma unroll
        for (int d = 0; d < C::NDT; ++d) {
            const u32x2 gv = *(const u32x2*)(gp + 16 * d);
            const float ga = bf_lo(gv.x), gb = bf_hi(gv.x), gc = bf_lo(gv.y), gd = bf_hi(gv.y);
            const float ya = O[d].x * rinv * (ga * __builtin_amdgcn_rcpf(1.0f + __expf(-ga))), yb = O[d].y * rinv * (gb * __builtin_amdgcn_rcpf(1.0f + __expf(-gb)));
            const float yc = O[d].z * rinv * (gc * __builtin_amdgcn_rcpf(1.0f + __expf(-gc))), yd = O[d].w * rinv * (gd * __builtin_amdgcn_rcpf(1.0f + __expf(-gd)));
            *(u32x2*)(op + 16 * d) = (u32x2){cvt_pk_bf16(ya, yb), cvt_pk_bf16(yc, yd)};
        }
    }
    __syncthreads();
#undef BAND_DMA
}

__device__ __forceinline__ void p2_mixers(const Args& A, LAS unsigned char* lds, int wave, int lane, int vcu, int G) {
    for (int v = vcu; v < 256; v += G) {
        if (v < 128) { const int bh = v >> 3, p = v & 7; band_unit<256, false>(A, lds, bh >> 2, bh & 3, 15 - p, wave, lane); band_unit<256, false>(A, lds, bh >> 2, bh & 3, p, wave, lane); }
        else { const int a = v - 128, bh = a >> 2, q = a & 3;
#pragma unroll 1
            for (int i = 3; i >= 0; --i) band_unit<128, true>(A, lds, bh >> 3, bh & 7, q + 4 * i, wave, lane); }
    }
}

__device__ __forceinline__ void p2_mixers_workers(const Args& A, LAS unsigned char* lds, int wave, int lane, int wv) {
    if (wv < 128) { const int bh = wv >> 3, p = wv & 7; band_unit<256, false>(A, lds, bh >> 2, bh & 3, 15 - p, wave, lane); band_unit<256, false>(A, lds, bh >> 2, bh & 3, p, wave, lane); }
    constexpr int L0 = 8 * (NG1 - 128);
    const int a0 = wv >= 128 ? 8 * (wv - 128) : L0 + wv, na = wv >= 128 ? 8 : (L0 + wv < 512 ? 1 : 0);
#pragma unroll 1
    for (int i = na - 1; i >= 0; --i) { const int a = a0 + i, bh = a >> 4, idx = a & 15, cp = 2 * (idx & 7) + (idx >> 3); band_unit<128, true>(A, lds, bh >> 3, bh & 7, cp, wave, lane); }
}

__device__ __forceinline__ void p4_router(const Args& A, LAS unsigned char* lds, int wave, int lane, int G) {
    const bf16_t* H1 = (const bf16_t*)(A.ws + WS_H1); const float* RB = A.in[I_RB];
    unsigned char* rt = A.ws + WS_RT;
    const bf16_t* RWT = (const bf16_t*)(rt + RT_RWT);
    int* TOPE = (int*)(rt + RT_TOPE); float* TOPW = (float*)(rt + RT_TOPW); float* RSTD = (float*)(rt + RT_RSTD); int* LRANK = (int*)(rt + RT_LRANK); int* HIST = (int*)(rt + RT_HIST);
    const int tid = threadIdx.x, li = lane & 15, g4 = lane >> 4;
    LAS float* part = (LAS float*)lds;
    LAS float* ssqp = (LAS float*)(lds + 32768);
    LAS int* esel = (LAS int*)(ssqp + 256);
    LAS int* c0 = esel + 128;
    for (int blk = blockIdx.x; blk < NTOK / 32; blk += G) {
        const int tok0 = blk * 32;
        f32x4 acc[2][2];
#pragma unroll
        for (int mt = 0; mt < 2; ++mt)
#pragma unroll
            for (int nt = 0; nt < 2; ++nt) acc[mt][nt] = (f32x4){0.f, 0.f, 0.f, 0.f};
        float sq[2] = {0.f, 0.f};
#pragma unroll
        for (int hs = 0; hs < 2; ++hs) {
            bf16x8 af[2][4], bh[2][4], bl[2][4];
#pragma unroll
            for (int s = 0; s < 4; ++s) {
                const int k = 256 * wave + 32 * (4 * hs + s) + 8 * g4;
#pragma unroll
                for (int mt = 0; mt < 2; ++mt) af[mt][s] = *(const bf16x8*)(H1 + (size_t)(tok0 + 16 * mt + li) * DM + k);
#pragma unroll
                for (int nt = 0; nt < 2; ++nt) { bh[nt][s] = *(const bf16x8*)(RWT + (size_t)(16 * nt + li) * 2048 + k); bl[nt][s] = *(const bf16x8*)(RWT + 32 * 2048 + (size_t)(16 * nt + li) * 2048 + k); }
            }
#pragma unroll
            for (int s = 0; s < 4; ++s)
#pragma unroll
                for (int mt = 0; mt < 2; ++mt) {
                    const u32x4 au = __builtin_bit_cast(u32x4, af[mt][s]);
#pragma unroll
                    for (int e = 0; e < 4; ++e) { const float x0 = bf_lo(au[e]), x1 = bf_hi(au[e]); sq[mt] += x0 * x0 + x1 * x1; }
#pragma unroll
                    for (int nt = 0; nt < 2; ++nt) {
                        acc[mt][nt] = __builtin_amdgcn_mfma_f32_16x16x32_bf16(af[mt][s], bh[nt][s], acc[mt][nt], 0, 0, 0);
                        acc[mt][nt] = __builtin_amdgcn_mfma_f32_16x16x32_bf16(af[mt][s], bl[nt][s], acc[mt][nt], 0, 0, 0);
                    }
                }
        }
#pragma unroll
        for (int mt = 0; mt < 2; ++mt) {
            float q = sq[mt]; q += __shfl_xor(q, 16); q += __shfl_xor(q, 32);
            if (g4 == 0) ssqp[wave * 32 + 16 * mt + li] = q;
#pragma unroll
            for (int nt = 0; nt < 2; ++nt)
#pragma unroll
                for (int r = 0; r < 4; ++r) part[(wave * 32 + 16 * mt + 4 * g4 + r) * 32 + 16 * nt + li] = acc[mt][nt][r];
        }
        __syncthreads();
#pragma unroll
        for (int pp = 0; pp < 2; ++pp) {
            const int p = tid + 512 * pp, tok = p >> 5, j = p & 31; float s = 0.f, q = 0.f;
#pragma unroll
            for (int w = 0; w < 8; ++w) { s += part[(w * 32 + tok) * 32 + j]; q += ssqp[w * 32 + tok]; }
            const float rstd = 1.0f / sqrtf(q * (1.f / DM) + NORM_EPS);
            float v = s * rstd + RB[j];
            float lv[4]; int le[4];
#pragma unroll
            for (int k = 0; k < 4; ++k) {
                float bv = v; int bi = j;
#pragma unroll
                for (int off = 16; off >= 1; off >>= 1) { const float ov = __shfl_xor(bv, off); const int oi = __shfl_xor(bi, off); const bool take = (ov > bv) || (ov == bv && oi < bi); bv = take ? ov : bv; bi = take ? oi : bi; }
                lv[k] = bv; le[k] = bi; v = (j == bi) ? -3.0e38f : v;
            }
            if (j == 0) {
                const float e1 = __expf(lv[1] - lv[0]), e2 = __expf(lv[2] - lv[0]), e3 = __expf(lv[3] - lv[0]); const float inv = 1.0f / (1.0f + e1 + e2 + e3);
                RSTD[tok0 + tok] = rstd;
                *(i32x4*)(TOPE + (size_t)(tok0 + tok) * 4) = (i32x4){le[0], le[1], le[2], le[3]};
                *(f32x4*)(TOPW + (size_t)(tok0 + tok) * 4) = (f32x4){inv, e1 * inv, e2 * inv, e3 * inv};
                *(LAS i32x4*)(esel + tok * 4) = (i32x4){le[0], le[1], le[2], le[3]};
            }
        }
        __syncthreads();
        int myrank = 0, mycnt = 0, mye = -1;
        if (wave < 2) {
            mye = esel[64 * wave + lane];
            for (int j = 0; j < 32; ++j) {
                const unsigned long long m = __ballot(mye == j);
                if (mye == j) myrank = __popcll(m & ((1ull << lane) - 1ull));
                if (lane == j) mycnt = __popcll(m);
            }
            if (wave == 0 && lane < 32) c0[lane] = mycnt;
        }
        __syncthreads();
        if (wave < 2) {
            if (wave == 1) myrank += c0[mye];
            LRANK[tok0 * 4 + 64 * wave + lane] = myrank;
            if (wave == 1 && lane < 32) HIST[blk * 32 + lane] = c0[lane] + mycnt;
        }
        __syncthreads();
    }
}

__device__ __forceinline__ void p5_scatter(const Args& A, LAS unsigned char* lds, int wave, int lane, int G) {
    const bf16_t* H1 = (const bf16_t*)(A.ws + WS_H1); const float* g2 = A.in[I_G2];
    unsigned char* rt = A.ws + WS_RT; unsigned* ctl = (unsigned*)(A.ws + WS_CTL);
    const int* TOPE = (const int*)(rt + RT_TOPE); const float* TOPW = (const float*)(rt + RT_TOPW); const float* RSTD = (const float*)(rt + RT_RSTD); const int* LRANK = (const int*)(rt + RT_LRANK); const int* HIST = (const int*)(rt + RT_HIST);
    int* TOKPOS = (int*)(rt + RT_TOKPOS); float* SLOTW = (float*)(rt + RT_SLOTW);
    unsigned char* XG = A.ws + WS_XG;
    const int tid = threadIdx.x;
    LAS int* psum = (LAS int*)lds; LAS int* pin = psum + 512; LAS int* cnt = pin + 512; LAS int* pad = cnt + 32; LAS int* pst = pad + 32; LAS int* basee = pst + 32;
    f32x4 g2v[2][4];
#pragma unroll
    for (int h = 0; h < 2; ++h)
#pragma unroll
        for (int q = 0; q < 4; ++q) g2v[h][q] = ((const f32x4*)g2)[4 * (lane + 64 * h) + q];
    for (int blk = blockIdx.x; blk < NTOK / 32; blk += G) {
        const int tok0 = blk * 32;
        { const int e = tid & 31, pt = tid >> 5; int s = 0, inp = 0;
            for (int bb = 0; bb < 16; ++bb) { const int b2 = pt * 16 + bb; const int c = HIST[b2 * 32 + e]; s += c; inp += (b2 < blk) ? c : 0; }
            psum[pt * 32 + e] = s; pin[pt * 32 + e] = inp; }
        __syncthreads();
        if (tid < 32) { int tot = 0, bs = 0; for (int pt = 0; pt < 16; ++pt) { tot += psum[pt * 32 + tid]; bs += pin[pt * 32 + tid]; } cnt[tid] = tot; pad[tid] = (tot + 255) & ~255; basee[tid] = bs; }
        __syncthreads();
        if (tid < 32) { int ps = 0; for (int e = 0; e < tid; ++e) ps += pad[e]; pst[tid] = ps; basee[tid] += ps; }
        __syncthreads();
        if (blk == 0 && tid == 0) { int mt = 0; for (int e = 0; e < 32; ++e) { const int n = pad[e] >> 8; for (int i = 0; i < n; ++i) { __hip_atomic_store(ctl + CW_MTE + mt, (unsigned)e, RLX_AGENT); ++mt; } } __hip_atomic_store(ctl + CW_NMT, (unsigned)mt, RLX_AGENT); }
        int pos = 0;
        if (lane < 16) { const int a = (tok0 + 4 * wave) * 4 + lane; const int e = TOPE[a]; pos = basee[e] + LRANK[a]; TOKPOS[a] = pos; SLOTW[pos] = TOPW[a]; }
        float rstd4 = 0.f; if (lane < 4) rstd4 = RSTD[tok0 + 4 * wave + lane];
        u32x4 hv[4][2][2];
#pragma unroll
        for (int i = 0; i < 4; ++i)
#pragma unroll
            for (int h = 0; h < 2; ++h) { const u32x4* xr = (const u32x4*)(H1 + (size_t)(tok0 + 4 * wave + i) * DM + 16 * (lane + 64 * h)); hv[i][h][0] = xr[0]; hv[i][h][1] = xr[1]; }
#pragma unroll
        for (int i = 0; i < 4; ++i) {
            const float rstd = __shfl(rstd4, i);
            const int p0 = __shfl(pos, 4 * i), p1 = __shfl(pos, 4 * i + 1), p2 = __shfl(pos, 4 * i + 2), p3 = __shfl(pos, 4 * i + 3);
#pragma unroll
            for (int h = 0; h < 2; ++h) {
                unsigned o[4];
#pragma unroll
                for (int q = 0; q < 4; ++q) {
                    const unsigned w0 = hv[i][h][q >> 1][2 * (q & 1)], w1 = hv[i][h][q >> 1][2 * (q & 1) + 1];
                    const f32x4 g = g2v[h][q];
                    o[q] = cvt_pk4_fp8(bf_lo(w0) * rstd * g.x, bf_hi(w0) * rstd * g.y, bf_lo(w1) * rstd * g.z, bf_hi(w1) * rstd * g.w);
                }
                const u32x4 ov = (u32x4){o[0], o[1], o[2], o[3]};
                const size_t co = (size_t)16 * (lane + 64 * h);
                *(u32x4*)(XG + (size_t)p0 * DM + co) = ov; *(u32x4*)(XG + (size_t)p1 * DM + co) = ov;
                *(u32x4*)(XG + (size_t)p2 * DM + co) = ov; *(u32x4*)(XG + (size_t)p3 * DM + co) = ov;
            }
        }
        {
            const int e = blk & 31, part = blk >> 5;
            const int r0 = pst[e] + cnt[e], r1 = pst[e] + pad[e];
            for (int r = r0 + part * 8 + wave; r < r1; r += 64) {
                u32x4* o = (u32x4*)(XG + (size_t)r * DM);
#pragma unroll
                for (int j = 0; j < 2; ++j) o[lane + 64 * j] = (u32x4){0u, 0u, 0u, 0u};
                if (lane == 0) SLOTW[r] = 0.f;
            }
        }
        __syncthreads();
    }
}

typedef float f32x2 __attribute__((ext_vector_type(2)));
__device__ __forceinline__ f32x4 fp8x4_to_f32(unsigned u) { const f32x2 lo = __builtin_amdgcn_cvt_pk_f32_fp8((int)u, false), hi = __builtin_amdgcn_cvt_pk_f32_fp8((int)u, true); return (f32x4){lo.x, lo.y, hi.x, hi.y}; }
__device__ __forceinline__ void p8_final(const Args& A, int wave, int lane, int vcu, int G) {
    const bf16_t* H1 = (const bf16_t*)(A.ws + WS_H1); const float* gf = A.in[I_GF]; const unsigned char* YB = A.ws + WS_YB;
    const int* TOKPOS = (const int*)(A.ws + WS_RT + RT_TOKPOS);
    const int gw = vcu * 8 + wave, NGW = G * 8;
    for (int tok0 = gw; tok0 < NTOK; tok0 += 4 * NGW) {
        int pos = 0; { const int t = tok0 + (lane >> 2) * NGW; if (lane < 16 && t < NTOK) pos = TOKPOS[t * 4 + (lane & 3)]; }
        unsigned yr[2][4][8]; u32x2 hr[2][8];
#define P8_LOAD(i_, bf_) do { const int t_ = tok0 + (i_) * NGW; if (t_ < NTOK) { \
            const u32x2* xr_ = (const u32x2*)(H1 + (size_t)t_ * DM) + lane; \
            _Pragma("unroll") for (int k = 0; k < 4; ++k) { const unsigned* y_ = (const unsigned*)(YB + (size_t)__shfl(pos, 4 * (i_) + k) * DM) + lane; \
                _Pragma("unroll") for (int j = 0; j < 8; ++j) yr[bf_][k][j] = __builtin_nontemporal_load(y_ + 64 * j); } \
            _Pragma("unroll") for (int j = 0; j < 8; ++j) hr[bf_][j] = __builtin_nontemporal_load(xr_ + 64 * j); } } while (0)
        P8_LOAD(0, 0);
#pragma unroll
        for (int i = 0; i < 4; ++i) {
            const int tok = tok0 + i * NGW;
            if (i + 1 < 4) P8_LOAD(i + 1, (i + 1) & 1);
            if (tok < NTOK) {
                f32x4 v[8]; float s = 0.f;
#pragma unroll
                for (int j = 0; j < 8; ++j) {
                    const f32x4 y = (fp8x4_to_f32(yr[i & 1][0][j]) + fp8x4_to_f32(yr[i & 1][1][j])) + (fp8x4_to_f32(yr[i & 1][2][j]) + fp8x4_to_f32(yr[i & 1][3][j]));
                    const u32x2 hb = hr[i & 1][j];
                    v[j] = (f32x4){bf_lo(hb.x), bf_hi(hb.x), bf_lo(hb.y), bf_hi(hb.y)} + y * 0.0625f;
                    s += (v[j].x * v[j].x + v[j].y * v[j].y) + (v[j].z * v[j].z + v[j].w * v[j].w);
                }
                const float rstd = 1.0f / sqrtf(wave_sum(s) * (1.f / DM) + NORM_EPS);
                f32x4* o = (f32x4*)(A.out + (size_t)tok * DM) + lane;
#pragma unroll
                for (int j = 0; j < 8; ++j) __builtin_nontemporal_store(v[j] * rstd * ((const f32x4*)gf)[lane + 64 * j], o + 64 * j);
            }
        }
#undef P8_LOAD
    }
}

__global__ void __launch_bounds__(512, 2) hybrid_fwd(Args args) {
    extern __shared__ __attribute__((aligned(16))) unsigned char lds_raw[];
    LAS unsigned char* lds = (LAS unsigned char*)lds_raw;
    const int tid = threadIdx.x, lane = tid & 63, wave = __builtin_amdgcn_readfirstlane(tid >> 6);
    const int G = gridDim.x; const int bx = blockIdx.x; const int vcu = (G % 8 == 0) ? (bx % 8) * (G / 8) + bx / 8 : bx;
    unsigned char* ws = args.ws;
    unsigned* ctl = (unsigned*)(ws + WS_CTL);
    for (int u = tid; u < 256; u += 512) ((LAS unsigned*)(lds + CTL_OFF))[u] = 0u;
    __syncthreads();
    const int lo = args.ph_lo, hi = args.ph_hi;
    XcdBarrier bar = xcd_barrier_post(ctl + CW_BAR, (volatile LAS unsigned*)(lds + CTL_OFF), (unsigned)G);
#ifndef PHASE_MASK
#define PHASE_MASK 0x1ff
#endif
#define IN(k) (((PHASE_MASK >> (k)) & 1) && lo <= (k) && (k) < hi)
#ifdef PROBE_PHASE
    unsigned long long pr_t0 = 0, pr_t1 = 0;
#ifndef PROBE_PHASE_HI
#define PROBE_PHASE_HI PROBE_PHASE
#endif
#define PROBE_AT(k, which) do { if (which == 0 && (k) == PROBE_PHASE) pr_t0 = __builtin_amdgcn_s_memrealtime(); if (which == 1 && (k) == PROBE_PHASE_HI) pr_t1 = __builtin_amdgcn_s_memrealtime(); } while (0)
#else
#define PROBE_AT(k, which) do { } while (0)
#endif
#define SEAM(k) do { if (IN(k) && IN((k) + 1)) xcd_barrier(bar); PROBE_AT(k, 1); PROBE_AT((k) + 1, 0); } while (0)
    PROBE_AT(0, 0);

    if (G > NG1) {
        if (bx < NG1) {
            XcdBarrier barW = xcd_barrier_post(ctl + CW_BARW, (volatile LAS unsigned*)(lds + CTL_OFF + 16), (unsigned)NG1);
            const int wv = (NG1 % 8 == 0) ? (bx % 8) * (NG1 / 8) + bx / 8 : bx;
            p0_prologue(args, lds, wave, lane, bx, NG1);
            xcd_barrier(barW);
            {
                DenseOrder S; S.init(ws + WS_XN, ws + WS_WIN, NTOK, INC, NG1, bx);
                EpiInProj E{(bf16_t*)(ws + WS_PROJ), (const float*)(ws + WS_COS), (const float*)(ws + WS_SIN)};
                gemm_phase<EpiInProj, DenseOrder, false>(lds + RING_OFF, S, E, (size_t)HALF * KD * 2);
            }
            xcd_barrier(barW);
            p2_mixers_workers(args, lds, wave, lane, wv);
        }
        conv_drain<false>(args, lds, wave, lane, ctl + CW_CQ, 0, CONV_GU_ITEMS);
    } else {
        p0_prologue(args, lds, wave, lane, vcu, G);
        xcd_barrier(bar);
        {
            DenseOrder S; S.init(ws + WS_XN, ws + WS_WIN, NTOK, INC, G, bx);
            EpiInProj E{(bf16_t*)(ws + WS_PROJ), (const float*)(ws + WS_COS), (const float*)(ws + WS_SIN)};
            gemm_phase<EpiInProj, DenseOrder, false>(lds + RING_OFF, S, E, (size_t)HALF * KD * 2);
        }
        conv_drain<false>(args, lds, wave, lane, ctl + CW_CQ, 0, CONV_GU_ITEMS);
        xcd_barrier(bar);
        p2_mixers(args, lds, wave, lane, vcu, G);
    }
    xcd_barrier(bar);
    PROBE_AT(2, 1); PROBE_AT(3, 0);
    if (IN(3)) {
        DenseOrder S; S.init(ws + WS_MIX, ws + WS_WOUT, NTOK, DM, G, bx);
        EpiOutProj E{args.in[I_X], (bf16_t*)(ws + WS_H1)};
        gemm_phase<EpiOutProj, DenseOrder, false>(lds + RING_OFF, S, E, (size_t)HALF * KD * 2);
    }
    SEAM(3);
    if (IN(4)) { p4_router(args, lds, wave, lane, G); }
    SEAM(4);
    if (IN(5)) { p5_scatter(args, lds, wave, lane, G); }
    SEAM(5);
    if (IN(6) || IN(7)) {
        LAS int* mte = (LAS int*)(lds + TAB_OFF);
        if (tid < MAXMT) mte[tid] = (int)ld_u32_agent(ctl + CW_MTE + tid);
        if (tid == 0) mte[MAXMT] = (int)ld_u32_agent(ctl + CW_NMT);
        __syncthreads();
        if (tid < 32) { const int n = mte[MAXMT]; int first = -1, cntt = 0; for (int m = 0; m < n; ++m) if (mte[m] == tid) { if (first < 0) first = m; ++cntt; } mte[MOE_EST + tid] = first < 0 ? 0 : first; mte[MOE_ECN + tid] = cntt; }
        __syncthreads();
    }
    if (IN(6)) {
        if (bx < NG6 || G <= NG6) {
            const LAS int* mte = (const LAS int*)(lds + TAB_OFF);
            MoeOrder<16, 128> S; S.A = (const char*)(ws + WS_XG); S.B = (const char*)(ws + WS_WG); S.mte = mte; S.nmt = __builtin_amdgcn_readfirstlane(mte[MAXMT]); S.G = G <= NG6 ? G : NG6; S.c = bx;
            EpiGateUp E{ws + WS_HID, args.in[I_BG], args.in[I_BU]};
            gemm_phase<EpiGateUp, MoeOrder<16, 128>, true>(lds + RING_OFF, S, E, (size_t)(WS_WU - WS_WG));
        }
        conv_drain<true>(args, lds, wave, lane, ctl + CW_CQD, 0, CONV_D_ITEMS);
    }
    SEAM(6);
    if (IN(7)) {
        const LAS int* mte = (const LAS int*)(lds + TAB_OFF);
        MoeOrder<8, 256> S; S.A = (const char*)(ws + WS_HID); S.B = (const char*)(ws + WS_WD); S.mte = mte; S.nmt = __builtin_amdgcn_readfirstlane(mte[MAXMT]); S.G = G; S.c = bx;
        EpiDown E{ws + WS_YB, args.in[I_BD], (const float*)(ws + WS_RT + RT_SLOTW)};
        gemm_phase<EpiDown, MoeOrder<8, 256>, true>(lds + RING_OFF, S, E, (size_t)HALF * KD);
    }
    SEAM(7);
    if (IN(8)) { p8_final(args, wave, lane, vcu, G); }
#ifdef PROBE_PHASE
    PROBE_AT(8, 1);
    if (bx == 0) { const unsigned long long t2 = __builtin_amdgcn_s_memrealtime(), dt = (pr_t1 - pr_t0) * PROBE_MULT; while (__builtin_amdgcn_s_memrealtime() - t2 < dt) __builtin_amdgcn_s_sleep(16); }
#endif
#undef IN
#undef SEAM
}
}

#ifndef N_LAUNCHES
#define N_LAUNCHES 1
#endif

extern "C" void kernel_launch(void* const* d_in, const int* in_sizes, int n_in, void* d_out, int out_size, void* d_ws, size_t ws_size, hipStream_t stream) {
    static int grid = 0;
    if (grid == 0) {
        if (n_in != 16 || out_size != NTOK * DM || ws_size < WS_END) { fprintf(stderr, "kernel_launch: unexpected shapes (n_in %d out %d ws %zu)\n", n_in, out_size, ws_size); grid = -1; return; }
        int dev = 0, cus = 0, per_cu = 0;
        if (hipGetDevice(&dev) != hipSuccess || hipDeviceGetAttribute(&cus, hipDeviceAttributeMultiprocessorCount, dev) != hipSuccess) { grid = -1; return; }
        if (hipFuncSetAttribute((const void*)hybrid_fwd, hipFuncAttributeMaxDynamicSharedMemorySize, LDS_BYTES) != hipSuccess) { fprintf(stderr, "kernel_launch: hipFuncSetAttribute failed\n"); grid = -1; return; }
        if (hipOccupancyMaxActiveBlocksPerMultiprocessor(&per_cu, (const void*)hybrid_fwd, 512, LDS_BYTES) != hipSuccess || per_cu < 1) { fprintf(stderr, "kernel_launch: occupancy query says %d\n", per_cu); (void)hipGetLastError(); per_cu = 1; }
        grid = cus;
    }
    if (grid < 0) return;
    (void)in_sizes;
    if (hipMemsetAsync((char*)d_ws + WS_CTL, 0, CTL_ZERO_BYTES, stream) != hipSuccess) { fprintf(stderr, "kernel_launch: memset failed\n"); return; }
    Args a{};
    for (int i = 0; i < 16; ++i) a.in[i] = (const float*)d_in[i];
    a.out = (float*)d_out; a.ws = (unsigned char*)d_ws;
#if N_LAUNCHES == 1
    a.ph_lo = 0; a.ph_hi = NPHASE;
    hipLaunchKernelGGL(hybrid_fwd, dim3(grid), dim3(512), LDS_BYTES, stream, a);
#else
    for (int p = 0; p < NPHASE; ++p) { a.ph_lo = p; a.ph_hi = p + 1; hipLaunchKernelGGL(hybrid_fwd, dim3(grid), dim3(512), LDS_BYTES, stream, a); }
#endif
    const hipError_t le = hipPeekAtLastError();
    if (le != hipSuccess) fprintf(stderr, "kernel_launch: launch failed: %s\n", hipGetErrorName(le));
}
```

```cpp
#include <hip/hip_runtime.h>
#include <cstdio>
#include <cstdint>

namespace {
#define GAS __attribute__((address_space(1)))
#define LAS __attribute__((address_space(3)))
typedef unsigned short bf16_t;
typedef short bf16x8 __attribute__((ext_vector_type(8)));
typedef short s16x4 __attribute__((ext_vector_type(4)));
typedef float f32x4 __attribute__((ext_vector_type(4)));
typedef float f32x16 __attribute__((ext_vector_type(16)));
typedef unsigned u32x4 __attribute__((ext_vector_type(4)));
typedef unsigned u32x2 __attribute__((ext_vector_type(2)));
typedef int i32x8 __attribute__((ext_vector_type(8)));
typedef int i32x4 __attribute__((ext_vector_type(4)));

constexpr int NTOK = 8192, DM = 2048, SEQ = 2048, NBATCH = 4, NCH = 32, CH = 64;
constexpr int INC = 7168;
constexpr int OFF_RQ = 0, OFF_RK = 1024, OFF_RV = 2048, OFF_RG = 3072, OFF_AQ = 4096, OFF_AK = 5120, OFF_AV = 6144;
constexpr int NEXP = 32, TOPK = 4, MAXMT = 160, MAXSLOT = MAXMT * 256;
constexpr float NORM_EPS = 1e-6f;
constexpr int NPHASE = 9;
constexpr int KD = 2048;

constexpr size_t MiB = 1u << 20;
constexpr size_t WS_CTL = 0, CTL_ZERO_BYTES = 1 * MiB;
constexpr size_t WS_XN = 1 * MiB;
constexpr size_t WS_WIN = 33 * MiB;
constexpr size_t WS_WOUT = 61 * MiB;
constexpr size_t WS_WG = 69 * MiB;
constexpr size_t WS_WU = 325 * MiB;
constexpr size_t WS_WD = 581 * MiB;
constexpr size_t WS_COS = 837 * MiB;
constexpr size_t WS_SIN = 841 * MiB;
constexpr size_t WS_PROJ = 845 * MiB;
constexpr size_t WS_MIX = 957 * MiB;
constexpr size_t WS_H1 = 989 * MiB;
constexpr size_t WS_RT = 1053 * MiB;
constexpr size_t WS_XG = 1055 * MiB;
constexpr size_t WS_HID = 1215 * MiB;
constexpr size_t WS_YB = 1375 * MiB;
constexpr size_t WS_END = 1535 * MiB;
constexpr size_t RT_TOPE = 0, RT_TOPW = 128 * 1024, RT_RSTD = 256 * 1024, RT_LRANK = 384 * 1024, RT_HIST = 512 * 1024, RT_TOKPOS = 640 * 1024, RT_SLOTW = 768 * 1024, RT_RWT = 1024 * 1024, RT_SRC = 1536 * 1024;
constexpr int CW_TMO = 0, CW_BAR = 4096, CW_WQ = 8192, CW_NMT = 8256, CW_MTE = 8320, CW_CQ = 8512, CW_CQD = 8576, CW_CQR = 8640, CW_BARW = 12288;
constexpr int MOE_EST = 512, MOE_ECN = 544, MOE_SRCL = 640;
constexpr int NG6 = 216;
constexpr int NG1 = 192;

constexpr int RING_OFF = 0, RING_BYTES = 131072;
constexpr int TAB_OFF = 147456;
constexpr int CTL_OFF = 151552;
constexpr int LDS_BYTES = 152576;

#define LDS_WAIT() asm volatile("s_waitcnt lgkmcnt(0)" ::: "memory")
#define VM_WAIT() asm volatile("s_waitcnt vmcnt(0)" ::: "memory")
#define RLX_AGENT __ATOMIC_RELAXED, __HIP_MEMORY_SCOPE_AGENT

__device__ __forceinline__ unsigned cvt_pk_bf16(float lo, float hi) { unsigned r; asm volatile("v_cvt_pk_bf16_f32 %0, %1, %2" : "=v"(r) : "v"(lo), "v"(hi)); return r; }
__device__ __forceinline__ unsigned cvt_pk4_fp8(float a, float b, float c, float d) { int p = 0; p = __builtin_amdgcn_cvt_pk_fp8_f32(a, b, p, false); p = __builtin_amdgcn_cvt_pk_fp8_f32(c, d, p, true); return (unsigned)p; }
__device__ __forceinline__ float bf_lo(unsigned u) { return __builtin_bit_cast(float, u << 16); }
__device__ __forceinline__ float bf_hi(unsigned u) { return __builtin_bit_cast(float, u & 0xffff0000u); }
__device__ __forceinline__ float wave_sum(float v) {
#pragma unroll
    for (int o = 1; o < 64; o <<= 1) v += __shfl_xor(v, o);
    return v;
}
__device__ __forceinline__ unsigned ld_u32_agent(const unsigned* p) { return __hip_atomic_load(p, RLX_AGENT); }

#define XB_TMO      128
#define XB_XCNT(j)  (256  + 64 * (j))
#define XB_XSUB(j)  (1280 + 64 * (j))
#define XB_XGEN(j)  (2304 + 64 * (j))
#define XB_TOP      3328
#define XB_TOPGEN   3392
#define XCD_BAR_WORDS 3456
#define XB_SPIN_CAP (1u << 18)
__device__ __forceinline__ unsigned xb_ld(unsigned* p)              { return __hip_atomic_load(p, __ATOMIC_RELAXED, __HIP_MEMORY_SCOPE_AGENT); }
__device__ __forceinline__ unsigned xb_add(unsigned* p, unsigned v) { return __hip_atomic_fetch_add(p, v, __ATOMIC_RELAXED, __HIP_MEMORY_SCOPE_AGENT); }
__device__ __forceinline__ unsigned xb_xcc_id() { return (unsigned)__builtin_amdgcn_s_getreg((3 << 11) | 20) & 0xFu; }
#define XB_SPIN(cond, bar) do { unsigned _sp = 0; while (cond) { __builtin_amdgcn_s_sleep(1); \
    if ((++_sp & 255u) == 0u) { if (xb_ld(&(bar)[XB_TMO])) break; if (_sp > XB_SPIN_CAP) { atomicAdd(&(bar)[XB_TMO], 1u); break; } } } } while (0)
struct XcdBarrier { unsigned* bar; unsigned x; volatile LAS unsigned* st; unsigned total; };
__device__ __forceinline__ XcdBarrier xcd_barrier_post(unsigned* bar, volatile LAS unsigned* st, unsigned total) {
    XcdBarrier b; b.bar = bar; b.x = xb_xcc_id(); b.st = st; b.total = total;
    if (threadIdx.x == 0) (void)xb_add(&bar[XB_XCNT(b.x)], 1u);
    return b;
}
__device__ __forceinline__ void xcd_barrier_complete(unsigned* bar, unsigned x, const unsigned G, unsigned& nloc, unsigned& nx) {
    unsigned sum, cnt, mine, sp = 0u;
    for (;;) {
        sum = 0u; cnt = 0u; mine = 0u;
#pragma unroll
        for (unsigned j = 0; j < 16; ++j) { const unsigned c = xb_ld(&bar[XB_XCNT(j)]); sum += c; cnt += (c > 0u) ? 1u : 0u; mine = (j == x) ? c : mine; }
        if (sum == G) break;
        __builtin_amdgcn_s_sleep(1);
        if ((++sp & 255u) == 0u) { if (xb_ld(&bar[XB_TMO])) break; if (sp > XB_SPIN_CAP) { atomicAdd(&bar[XB_TMO], 1u); break; } }
    }
    nloc = mine > 0u ? mine : 1u; nx = cnt > 0u ? cnt : 1u;
}
__device__ __forceinline__ void xcd_barrier(const XcdBarrier& b) {
    asm volatile("s_waitcnt vmcnt(0)" ::: "memory");
    __syncthreads();
    if (threadIdx.x == 0) {
        unsigned* bar = b.bar;
        __builtin_amdgcn_s_waitcnt(0);
        unsigned nloc = b.st[0], nx = b.st[1];
        if (nloc == 0u) { xcd_barrier_complete(bar, b.x, b.total, nloc, nx); b.st[0] = nloc; b.st[1] = nx; }
        const unsigned old = xb_add(&bar[XB_XSUB(b.x)], 1u);
        const unsigned gen = old / nloc;
        if (old + 1u == (gen + 1u) * nloc) {
            __builtin_amdgcn_fence(__ATOMIC_RELEASE, "agent");
            asm volatile("s_waitcnt vmcnt(0)" ::: "memory");
            const unsigned og = xb_add(&bar[XB_TOP], 1u);
            const unsigned tg = og / nx;
            if (og + 1u == (tg + 1u) * nx) xb_add(&bar[XB_TOPGEN], 1u);
            else XB_SPIN(xb_ld(&bar[XB_TOPGEN]) == tg, bar);
            __builtin_amdgcn_fence(__ATOMIC_ACQUIRE, "agent");
            xb_add(&bar[XB_XGEN(b.x)], 1u);
            asm volatile("s_waitcnt vmcnt(0)" ::: "memory");
        } else {
            XB_SPIN(xb_ld(&bar[XB_XGEN(b.x)]) == gen, bar);
            __builtin_amdgcn_fence(__ATOMIC_ACQUIRE, "agent");
            asm volatile("s_waitcnt vmcnt(0)" ::: "memory");
        }
    }
    __syncthreads();
}

constexpr int BM = 256, BK = 64, HALF = 128, HTB = HALF * BK * 2, NXCD = 8, WGM = 8;
__device__ __forceinline__ int lds_byte(int r, int c) { const int st = (r >> 4) * 2 + (c >> 5), rr = r & 15, cc = c & 31, ob = rr * 64 + cc * 2; return st * 1024 + (ob ^ (((ob >> 9) & 1) << 5)); }
__device__ __forceinline__ void stage_rc(int b, int& R, int& C) { const int st = b / 1024, sb = b % 1024, swz = sb ^ (((sb >> 9) & 1) << 5); R = (st >> 1) * 16 + swz / 64; C = (st & 1) * 32 + (swz % 64) / 2; }
__device__ __forceinline__ int perm32(int rho) { const int n = rho >> 4, i = rho & 15; return 8 * (i >> 2) + 4 * n + (i & 3); }

struct Unit { const char* a; const char* b; int pm, pn, e; };

struct DenseOrder {
    static constexpr bool GATHER = false; const int* src = nullptr;
    const char* A; const char* B; int nM, nN, nwg, G, c;
    __device__ void init(const void* A_, const void* B_, int M, int N, int G_, int c_) { A = (const char*)A_; B = (const char*)B_; nM = M / BM; nN = N / BM; nwg = nM * nN; G = G_; c = c_; }
    __device__ __forceinline__ bool next(int i, Unit& u) const {
        const long L = (long)i * G + c; if (L >= nwg) return false;
        int wgid = (int)L; { const int q = nwg / NXCD, r = nwg % NXCD, xcd = wgid % NXCD, off = wgid / NXCD; wgid = (xcd < r ? xcd * (q + 1) : r * (q + 1) + (xcd - r) * q) + off; }
        const int nig = WGM * nN, gid = wgid / nig, fm = gid * WGM, gsz = (nM - fm) < WGM ? (nM - fm) : WGM;
        u.pm = fm + ((wgid % nig) % gsz); u.pn = (wgid % nig) / gsz; u.e = 0;
        u.a = A + (size_t)u.pm * (size_t)(BM * KD * 2); u.b = B + (size_t)u.pn * (size_t)(BM * KD * 2); return true;
    }
};
template <int NT, int BROWS  , bool GATHER_ = false> struct MoeOrder {
    static constexpr bool GATHER = GATHER_; const int* src = nullptr;
    const char* A; const char* B; const LAS int* mte; int nmt, G, c;
    __device__ __forceinline__ bool next(int i, Unit& u) const {
        const int U = nmt * NT;
        int j;
        if ((G & 7) == 0) { const int q = (U + 7) >> 3, Wx = G >> 3, jl = i * Wx + (c >> 3); if (jl >= q) return false; j = (c & 7) * q + jl; }
        else j = i * G + c;
        if (j >= U) return false;
        const int e = __builtin_amdgcn_readfirstlane(mte[j / NT]);
        const int es = __builtin_amdgcn_readfirstlane(mte[MOE_EST + e]), ec = __builtin_amdgcn_readfirstlane(mte[MOE_ECN + e]);
        const int idx = j - es * NT, nt = idx / ec, mt = es + idx % ec;
        u.pm = mt; u.pn = nt; u.e = e;
        u.a = GATHER ? A : A + (size_t)mt * (size_t)(BM * KD); u.b = B + ((size_t)e * 2048 + (size_t)nt * BROWS) * (size_t)KD; return true;
    }
};

__device__ __forceinline__ unsigned lds_addr(const volatile LAS void* p) { return (unsigned)(size_t)p; }
__device__ __forceinline__ void glds4_asm(const void* gsrc, unsigned lds_dst) {
    unsigned keep;
    asm volatile("s_mov_b32 %0, m0\n\ts_mov_b32 m0, %2\n\ts_nop 0\n\tglobal_load_lds_dword %1, off\n\ts_mov_b32 m0, %0" : "=&s"(keep) : "v"(gsrc), "s"(lds_dst) : "memory");
}
template <class Epi, class Sched, bool FP8>
__device__ __forceinline__ void gemm_phase(LAS unsigned char* lds, const Sched& S, const Epi& E, const size_t bhstep) {
    const int tid = threadIdx.x, wid = __builtin_amdgcn_readfirstlane(tid >> 6), lane = tid & 63, wr = wid >> 2, wc = wid & 3, fr = lane & 15, fq = lane >> 4;
    constexpr int KROWB = FP8 ? KD : KD * 2, nt = KROWB / 128;
    unsigned voffA[2], voffB[2];
#pragma unroll
    for (int i = 0; i < 2; ++i) { int R, C; stage_rc(tid * 16 + i * 8192, R, C); const int Rb = Epi::PERM ? ((R & ~31) + perm32(R & 31)) : R;
        voffA[i] = (unsigned)(R * KROWB + C * 2); voffB[i] = (unsigned)(Rb * KROWB + C * 2); }
    const size_t kstep = (size_t)(BK * 2);
    const size_t hstep = (size_t)HALF * KROWB;
    const unsigned ldsw = (unsigned)wid * 1024u;
    const int aoff = lds_byte(wr * 64 + fr, fq * 8), boff = lds_byte(wc * 32 + fr, fq * 8);
#define PG8_SA(b, h) (((b) * 2 + (h)) * HTB)
#define PG8_SB(b, h) ((4 + (b) * 2 + (h)) * HTB)
    constexpr bool GATH = Sched::GATHER;
    unsigned goff[2][2] = {{0u, 0u}, {0u, 0u}};
    int gR[2] = {0, 0}; unsigned gC[2] = {0u, 0u};
    if constexpr (GATH) {
#pragma unroll
        for (int i = 0; i < 2; ++i) { int R, C; stage_rc(tid * 16 + i * 8192, R, C); gR[i] = R; gC[i] = (unsigned)(C * 2); }
    }
    const LAS int* srcl = (const LAS int*)(lds + TAB_OFF) + MOE_SRCL;
#define PG8_STAGE_A(b, h, kbase) do { if constexpr (GATH) PG8_STAGE(PG8_SA(b, h), (kbase), goff[h]); else PG8_STAGE(PG8_SA(b, h), (kbase) + ((h) ? hstep : (size_t)0), voffA); } while (0)
#define PG8_STAGE(bufoff, gbase, voff) do { _Pragma("unroll") for (int _i = 0; _i < 2; ++_i) \
        __builtin_amdgcn_global_load_lds((const GAS unsigned*)((const GAS char*)(gbase) + (voff)[_i]), (LAS unsigned*)(lds + (bufoff) + ldsw + _i * 8192), 16, 0, 0); } while (0)
#define PG8_LDA(dst, b, h) do { _Pragma("unroll") for (int m = 0; m < 4; ++m) { const i32x4 lo_ = *(const LAS i32x4*)(lds + PG8_SA(b, h) + aoff + m * 2048), hi_ = *(const LAS i32x4*)(lds + PG8_SA(b, h) + aoff + m * 2048 + 1024); \
        dst[m] = __builtin_shufflevector(lo_, hi_, 0, 1, 2, 3, 4, 5, 6, 7); } } while (0)
#define PG8_LDB(dst, b, h) do { _Pragma("unroll") for (int n = 0; n < 2; ++n) { const i32x4 lo_ = *(const LAS i32x4*)(lds + PG8_SB(b, h) + boff + n * 2048), hi_ = *(const LAS i32x4*)(lds + PG8_SB(b, h) + boff + n * 2048 + 1024); \
        dst[n] = __builtin_shufflevector(lo_, hi_, 0, 1, 2, 3, 4, 5, 6, 7); } } while (0)
#define PG8_MMA(ai, bj, At, Bt) do { __builtin_amdgcn_s_setprio(1); _Pragma("unroll") for (int m = 0; m < 4; ++m) _Pragma("unroll") for (int n = 0; n < 2; ++n) { \
        if constexpr (FP8) { asm volatile("v_mfma_scale_f32_16x16x128_f8f6f4 %0, %1, %2, %0, %3, %3 op_sel_hi:[0,0,0]" : "+v"(acc[ai][bj][m][n]) : "v"(Bt[n]), "v"(At[m]), "v"(mxscale)); } \
        else { acc[ai][bj][m][n] = __builtin_amdgcn_mfma_f32_16x16x32_bf16(__builtin_bit_cast(bf16x8, __builtin_shufflevector(Bt[n], Bt[n], 0, 1, 2, 3)), __builtin_bit_cast(bf16x8, __builtin_shufflevector(At[m], At[m], 0, 1, 2, 3)), acc[ai][bj][m][n], 0, 0, 0); \
               acc[ai][bj][m][n] = __builtin_amdgcn_mfma_f32_16x16x32_bf16(__builtin_bit_cast(bf16x8, __builtin_shufflevector(Bt[n], Bt[n], 4, 5, 6, 7)), __builtin_bit_cast(bf16x8, __builtin_shufflevector(At[m], At[m], 4, 5, 6, 7)), acc[ai][bj][m][n], 0, 0, 0); } } \
        __builtin_amdgcn_s_setprio(0); } while (0)
#define PG8_WAIT_V(n) asm volatile("s_waitcnt vmcnt(" #n ")" ::: "memory")
#define PG8_WAIT_L(n) asm volatile("s_waitcnt lgkmcnt(" #n ")" ::: "memory")
#define PG8_BAR __builtin_amdgcn_s_barrier()
#define PG8_SCHED __builtin_amdgcn_sched_barrier(0)
    Unit cur, nxt; int ui = 0;
    if (!S.next(0, cur)) return;
    f32x4 acc[2][2][4][2];
#pragma unroll
    for (int a = 0; a < 2; ++a)
#pragma unroll
        for (int b = 0; b < 2; ++b)
#pragma unroll
            for (int m = 0; m < 4; ++m)
#pragma unroll
                for (int n = 0; n < 2; ++n) acc[a][b][m][n] = (f32x4){0.f, 0.f, 0.f, 0.f};
    i32x8 At[4], B0[2], B1[2];
    int mxscale = 0x7F7F7F7F; asm volatile("" : "+v"(mxscale));
    const char* cA = cur.a; const char* cB = cur.b;
    if constexpr (GATH) {
#pragma unroll
        for (int h = 0; h < 2; ++h)
#pragma unroll
            for (int i = 0; i < 2; ++i) goff[h][i] = (unsigned)S.src[cur.pm * BM + h * HALF + gR[i]] * (unsigned)KROWB + gC[i];
    }
    PG8_STAGE(PG8_SB(0, 0), cB, voffB); PG8_STAGE(PG8_SB(0, 1), cB + bhstep, voffB); PG8_STAGE_A(0, 0, cA); PG8_STAGE_A(0, 1, cA);
    if (wr == 1) PG8_BAR;
    PG8_WAIT_V(2); PG8_BAR;
    PG8_STAGE(PG8_SB(1, 0), cB + kstep, voffB); PG8_STAGE_A(1, 0, cA + kstep); PG8_STAGE(PG8_SB(1, 1), cB + bhstep + kstep, voffB);
    PG8_WAIT_V(6); PG8_BAR;
    for (;;) {
        const bool has_next = S.next(ui + 1, nxt);
        const char* nA = has_next ? nxt.a : cA; const char* nB = has_next ? nxt.b : cB;
        if constexpr (GATH) {
            if (has_next && wid < 4) glds4_asm(S.src + nxt.pm * BM + 64 * wid + lane, __builtin_amdgcn_readfirstlane(lds_addr(srcl) + 256u * (unsigned)wid));
        }
        for (int t = 0; t < nt; t += 2) {
            const bool last = (t == nt - 2);
            const char* a1 = cA + (size_t)(t + 1) * kstep;
            const char* a2 = last ? nA : cA + (size_t)(t + 2) * kstep; const char* b2 = last ? nB : cB + (size_t)(t + 2) * kstep;
            const char* a3 = a2 + kstep; const char* b3 = b2 + kstep;
            PG8_LDB(B0, 0, 0); PG8_LDB(B1, 0, 1); PG8_SCHED; PG8_LDA(At, 0, 0); PG8_STAGE_A(1, 1, a1);
            if constexpr (GATH) {
                if (last && has_next) {
#pragma unroll
                    for (int h = 0; h < 2; ++h)
#pragma unroll
                        for (int i = 0; i < 2; ++i) goff[h][i] = (unsigned)srcl[h * HALF + gR[i]] * (unsigned)KROWB + gC[i];
                }
            }
            PG8_WAIT_V(8); PG8_WAIT_L(0); PG8_BAR; PG8_MMA(0, 0, At, B0); PG8_MMA(0, 1, At, B1); PG8_BAR; PG8_SCHED;
            PG8_LDA(At, 0, 1); PG8_STAGE(PG8_SB(0, 0), b2, voffB); PG8_STAGE(PG8_SB(0, 1), b2 + bhstep, voffB); PG8_STAGE_A(0, 0, a2);
            PG8_WAIT_V(8); PG8_WAIT_L(0); PG8_BAR; PG8_MMA(1, 0, At, B0); PG8_MMA(1, 1, At, B1); PG8_BAR; PG8_SCHED;
            PG8_LDB(B0, 1, 0); PG8_LDB(B1, 1, 1); PG8_SCHED; PG8_LDA(At, 1, 0); PG8_STAGE_A(0, 1, a2);
            PG8_WAIT_V(8); PG8_WAIT_L(0); PG8_BAR; PG8_MMA(0, 0, At, B0); PG8_MMA(0, 1, At, B1); PG8_BAR; PG8_SCHED;
            PG8_LDA(At, 1, 1); PG8_STAGE(PG8_SB(1, 0), b3, voffB); PG8_STAGE(PG8_SB(1, 1), b3 + bhstep, voffB); PG8_STAGE_A(1, 0, a3);
            PG8_WAIT_V(8); PG8_WAIT_L(0); PG8_BAR; PG8_MMA(1, 0, At, B0); PG8_MMA(1, 1, At, B1); PG8_BAR; PG8_SCHED;
        }
        if (wr == 0) PG8_BAR;
        if constexpr (FP8) { asm volatile("s_nop 15\n\ts_nop 15" ::: "memory"); }
        E(acc, cur, wr, wc, fr, fq);
        if (!has_next) break;
#pragma unroll
        for (int a = 0; a < 2; ++a)
#pragma unroll
            for (int b = 0; b < 2; ++b)
#pragma unroll
                for (int m = 0; m < 4; ++m)
#pragma unroll
                    for (int n = 0; n < 2; ++n) acc[a][b][m][n] = (f32x4){0.f, 0.f, 0.f, 0.f};
        cur = nxt; cA = nA; cB = nB; ++ui;
        if (wr == 1) PG8_BAR;
    }
    PG8_WAIT_V(0);
    PG8_BAR;
#undef PG8_SA
#undef PG8_SB
#undef PG8_STAGE
#undef PG8_STAGE_A
#undef PG8_LDA
#undef PG8_LDB
#undef PG8_MMA
#undef PG8_WAIT_V
#undef PG8_WAIT_L
#undef PG8_BAR
#undef PG8_SCHED
}

struct EpiInProj {
    static constexpr bool PERM = true;
    bf16_t* P; const float* cs; const float* sn;
    __device__ __forceinline__ void operator()(const f32x4 (&acc)[2][2][4][2], const Unit& u, int wr, int wc, int fr, int fq) const {
        const int row0 = u.pm * BM + wr * 64 + fr, colt = u.pn * BM, i0 = wc * 32 + 8 * fq;
        const bool rot = u.pn < 8; const float ksc = (u.pn >= 4 && u.pn < 8) ? 0.0625f : 1.f;
#pragma unroll
        for (int ai = 0; ai < 2; ++ai)
#pragma unroll
            for (int m = 0; m < 4; ++m) {
                const int row = row0 + ai * HALF + m * 16;
                f32x4 a0 = acc[ai][0][m][0], a1 = acc[ai][0][m][1], b0 = acc[ai][1][m][0], b1 = acc[ai][1][m][1];
                if (rot) {
                    const f32x4 c0 = *(const f32x4*)(cs + (size_t)row * 128 + i0), c1 = *(const f32x4*)(cs + (size_t)row * 128 + i0 + 4);
                    const f32x4 s0 = *(const f32x4*)(sn + (size_t)row * 128 + i0), s1 = *(const f32x4*)(sn + (size_t)row * 128 + i0 + 4);
                    const f32x4 o0 = (a0 * c0 - b0 * s0) * ksc, o1 = (a1 * c1 - b1 * s1) * ksc, p0 = (a0 * s0 + b0 * c0) * ksc, p1 = (a1 * s1 + b1 * c1) * ksc;
                    a0 = o0; a1 = o1; b0 = p0; b1 = p1;
                }
                bf16_t* rp = P + (size_t)row * INC + colt + i0;
                *(u32x4*)rp = (u32x4){cvt_pk_bf16(a0[0], a0[1]), cvt_pk_bf16(a0[2], a0[3]), cvt_pk_bf16(a1[0], a1[1]), cvt_pk_bf16(a1[2], a1[3])};
                *(u32x4*)(rp + HALF) = (u32x4){cvt_pk_bf16(b0[0], b0[1]), cvt_pk_bf16(b0[2], b0[3]), cvt_pk_bf16(b1[0], b1[1]), cvt_pk_bf16(b1[2], b1[3])};
            }
    }
};
struct EpiOutProj {
    static constexpr bool PERM = true;
    const float* X; bf16_t* H;
    __device__ __forceinline__ void operator()(const f32x4 (&acc)[2][2][4][2], const Unit& u, int wr, int wc, int fr, int fq) const {
        const int row0 = u.pm * BM + wr * 64 + fr, col0 = u.pn * BM + wc * 32 + 8 * fq;
#pragma unroll
        for (int ai = 0; ai < 2; ++ai)
#pragma unroll
            for (int m = 0; m < 4; ++m) {
                const size_t ro = (size_t)(row0 + ai * HALF + m * 16) * DM + col0;
#pragma unroll
                for (int bj = 0; bj < 2; ++bj) {
                    const f32x4 x0 = __builtin_nontemporal_load((const f32x4*)(X + ro + bj * HALF)), x1 = __builtin_nontemporal_load((const f32x4*)(X + ro + bj * HALF + 4));
                    const f32x4 h0 = acc[ai][bj][m][0] + x0, h1 = acc[ai][bj][m][1] + x1;
                    *(u32x4*)(H + ro + bj * HALF) = (u32x4){cvt_pk_bf16(h0[0], h0[1]), cvt_pk_bf16(h0[2], h0[3]), cvt_pk_bf16(h1[0], h1[1]), cvt_pk_bf16(h1[2], h1[3])};
                }
            }
    }
};
__device__ __forceinline__ float swiglu1(float g, float u) {
    g = fminf(g, 7.0f); u = fminf(fmaxf(u, -7.0f), 7.0f);
    const float sg = __builtin_amdgcn_rcpf(1.0f + __builtin_amdgcn_exp2f(-1.702f * 1.4426950408889634f * g));
    return (u + 1.0f) * g * sg;
}
__device__ __forceinline__ void store_pair16(unsigned char* base, size_t row_a, size_t row_b, int col_even, bool odd, u32x2 da, u32x2 db) {
    const unsigned s0 = odd ? da.x : db.x, s1 = odd ? da.y : db.y;
    const unsigned r0 = (unsigned)__shfl_xor((int)s0, 16), r1 = (unsigned)__shfl_xor((int)s1, 16);
    const u32x4 o = odd ? (u32x4){r0, r1, db.x, db.y} : (u32x4){da.x, da.y, r0, r1};
    *(u32x4*)(base + (odd ? row_b : row_a) * 2048 + col_even) = o;
}
struct EpiGateUp {
    static constexpr bool PERM = true;
    unsigned char* Hd; const float* bg; const float* bu;
    __device__ __forceinline__ void operator()(const f32x4 (&acc)[2][2][4][2], const Unit& u, int wr, int wc, int fr, int fq) const {
        const int row0 = u.pm * BM + wr * 64 + fr, colh = u.pn * HALF + wc * 32 + 8 * fq, col_even = u.pn * HALF + wc * 32 + 8 * (fq & ~1);
        const bool odd = fq & 1;
        const f32x4 g0 = *(const f32x4*)(bg + (size_t)u.e * 2048 + colh), g1 = *(const f32x4*)(bg + (size_t)u.e * 2048 + colh + 4);
        const f32x4 u0 = *(const f32x4*)(bu + (size_t)u.e * 2048 + colh), u1 = *(const f32x4*)(bu + (size_t)u.e * 2048 + colh + 4);
#pragma unroll
        for (int ai = 0; ai < 2; ++ai)
#pragma unroll
            for (int m = 0; m < 4; m += 2) {
                u32x2 d[2];
#pragma unroll
                for (int mm = 0; mm < 2; ++mm) {
                    const f32x4 ga = acc[ai][0][m + mm][0] * 0.015625f + g0, gb = acc[ai][0][m + mm][1] * 0.015625f + g1, ua = acc[ai][1][m + mm][0] * 0.015625f + u0, ub = acc[ai][1][m + mm][1] * 0.015625f + u1;
                    float h[8];
#pragma unroll
                    for (int j = 0; j < 4; ++j) { h[j] = swiglu1(ga[j], ua[j]); h[4 + j] = swiglu1(gb[j], ub[j]); }
                    d[mm] = (u32x2){cvt_pk4_fp8(h[0], h[1], h[2], h[3]), cvt_pk4_fp8(h[4], h[5], h[6], h[7])};
                }
                const size_t ra = (size_t)(row0 + ai * HALF + m * 16), rb = ra + 16;
                store_pair16(Hd, ra, rb, col_even, odd, d[0], d[1]);
            }
    }
};
struct EpiDown {
    static constexpr bool PERM = true;
    unsigned char* Y; const float* bd; const float* sw;
    __device__ __forceinline__ void operator()(const f32x4 (&acc)[2][2][4][2], const Unit& u, int wr, int wc, int fr, int fq) const {
        const int row0 = u.pm * BM + wr * 64 + fr, col0 = u.pn * BM + wc * 32 + 8 * fq, col_even = u.pn * BM + wc * 32 + 8 * (fq & ~1);
        const bool odd = fq & 1;
        f32x4 bv[2][2];
#pragma unroll
        for (int bj = 0; bj < 2; ++bj)
#pragma unroll
            for (int n = 0; n < 2; ++n) bv[bj][n] = *(const f32x4*)(bd + (size_t)u.e * 2048 + col0 + bj * HALF + 4 * n);
#pragma unroll
        for (int ai = 0; ai < 2; ++ai)
#pragma unroll
            for (int m = 0; m < 4; m += 2) {
                const int ra = row0 + ai * HALF + m * 16, rb = ra + 16;
                const float wa = sw[ra] * 16.f, wb = sw[rb] * 16.f;
#pragma unroll
                for (int bj = 0; bj < 2; ++bj) {
                    const f32x4 a0 = (acc[ai][bj][m][0] * 0.015625f + bv[bj][0]) * wa, a1 = (acc[ai][bj][m][1] * 0.015625f + bv[bj][1]) * wa;
                    const f32x4 b0 = (acc[ai][bj][m + 1][0] * 0.015625f + bv[bj][0]) * wb, b1 = (acc[ai][bj][m + 1][1] * 0.015625f + bv[bj][1]) * wb;
                    const u32x2 da = (u32x2){cvt_pk4_fp8(a0[0], a0[1], a0[2], a0[3]), cvt_pk4_fp8(a1[0], a1[1], a1[2], a1[3])};
                    const u32x2 db = (u32x2){cvt_pk4_fp8(b0[0], b0[1], b0[2], b0[3]), cvt_pk4_fp8(b1[0], b1[1], b1[2], b1[3])};
                    store_pair16(Y, (size_t)ra, (size_t)rb, col_even + bj * HALF, odd, da, db);
                }
            }
    }
};

struct Args { const float* in[16]; float* out; unsigned char* ws; int ph_lo, ph_hi; };
enum { I_X = 0, I_POS, I_G1, I_WIN, I_WOUT, I_RELB, I_G2, I_RW, I_RB, I_WG, I_BG, I_WU, I_BU, I_WD, I_BD, I_GF };

__device__ __forceinline__ void p0_transpose_item(const float* W, int N, bf16_t* WT, int kb, int nb, LAS unsigned* scr, int lane) {
    const int k0 = 128 * kb, n0 = 64 * nb, kq = lane >> 4, nq = lane & 15;
    f32x4 v[32];
#pragma unroll
    for (int i = 0; i < 32; ++i) { const int half = i >> 4, ii = i & 15; const int k = half * 64 + 2 * (kq + 4 * (ii >> 1)) + (ii & 1);
        v[i] = __builtin_nontemporal_load((const f32x4*)(W + (size_t)(k0 + k) * N + n0 + 4 * nq)); }
#pragma unroll
    for (int half = 0; half < 2; ++half)
#pragma unroll
        for (int a = 0; a < 8; ++a)
#pragma unroll
            for (int j = 0; j < 4; ++j) scr[(4 * nq + j) * 68 + half * 32 + kq + 4 * a] = cvt_pk_bf16(v[half * 16 + 2 * a][j], v[half * 16 + 2 * a + 1][j]);
    LDS_WAIT();
#pragma unroll
    for (int r = 0; r < 16; ++r) { const int n = 4 * r + kq; const u32x4 o = *(const LAS u32x4*)(scr + n * 68 + nq * 4); __builtin_nontemporal_store(o, (u32x4*)(WT + (size_t)(n0 + n) * KD + k0 + 8 * nq)); }
    LDS_WAIT();
}
__device__ __forceinline__ void p0_transpose_item_fp8(const float* W, unsigned char* WT, int kb, int nb, LAS unsigned* scr, int lane) {
    const int k0 = 256 * kb, n0 = 64 * nb, kq = lane >> 4, nq = lane & 15;
#pragma unroll
    for (int pass = 0; pass < 2; ++pass) {
        f32x4 v[32];
#pragma unroll
        for (int i = 0; i < 32; ++i) { const int q = i >> 4, a = (i >> 2) & 3, t = i & 3; const int k = pass * 128 + q * 64 + 4 * (kq + 4 * a) + t;
            v[i] = __builtin_nontemporal_load((const f32x4*)(W + (size_t)(k0 + k) * 2048 + n0 + 4 * nq)); }
#pragma unroll
        for (int q = 0; q < 2; ++q)
#pragma unroll
            for (int a = 0; a < 4; ++a)
#pragma unroll
                for (int j = 0; j < 4; ++j) { const int b = q * 16 + 4 * a;
                    scr[(4 * nq + j) * 68 + pass * 32 + q * 16 + kq + 4 * a] = cvt_pk4_fp8(v[b][j] * 64.f, v[b + 1][j] * 64.f, v[b + 2][j] * 64.f, v[b + 3][j] * 64.f); }
    }
    LDS_WAIT();
#pragma unroll
    for (int r = 0; r < 16; ++r) { const int n = 4 * r + kq; const u32x4 o = *(const LAS u32x4*)(scr + n * 68 + nq * 4); __builtin_nontemporal_store(o, (u32x4*)(WT + (size_t)(n0 + n) * 2048 + k0 + 16 * nq)); }
    LDS_WAIT();
}
__device__ __forceinline__ void sincos_d(double x, float& c, float& s) {
    const double TWO_OVER_PI = 0.63661977236758134308, P1 = 1.57079632673412561417e+00, P2 = 6.07710050650619224932e-11;
    const double fn = __builtin_rint(x * TWO_OVER_PI);
    double r = __builtin_fma(-fn, P1, x); r = __builtin_fma(-fn, P2, r);
    const int q = (int)((long long)fn & 3);
    const double z = r * r;
    double ps = -7.6471637318198164759e-13; ps = ps * z + 1.6059043836821614599e-10; ps = ps * z - 2.5052108385441718775e-08; ps = ps * z + 2.7557319223985890653e-06;
    ps = ps * z - 1.9841269841269841270e-04; ps = ps * z + 8.3333333333333333333e-03; ps = ps * z - 1.6666666666666666667e-01;
    const double sv = r + r * z * ps;
    double pc = 4.7794773323873852974e-14; pc = pc * z - 1.1470745597729724714e-11; pc = pc * z + 2.0876756987868098979e-09; pc = pc * z - 2.7557319223985890653e-07;
    pc = pc * z + 2.4801587301587301587e-05; pc = pc * z - 1.3888888888888888889e-03; pc = pc * z + 4.1666666666666666667e-02; pc = pc * z - 0.5;
    const double cv = 1.0 + z * pc;
    const double cc = (q == 0) ? cv : (q == 1) ? -sv : (q == 2) ? -cv : sv;
    const double ss = (q == 0) ? sv : (q == 1) ? cv : (q == 2) ? -sv : -cv;
    c = (float)cc; s = (float)ss;
}
__device__ __forceinline__ void p0_prologue(const Args& A, LAS unsigned char* lds, int wave, int lane, int vcu, int G) {
    unsigned char* ws = A.ws;
    LAS unsigned* scr = (LAS unsigned*)(lds + wave * 17408);
    const int gw = vcu * 8 + wave, NGW = G * 8;
    constexpr int I_IN = 16 * (INC / 64), I_OUT = 16 * 32;
    constexpr int NITEMS = I_IN + I_OUT;
    for (int it = gw; it < NITEMS; it += NGW) {
        int r = it;
        if (r < I_IN) { p0_transpose_item(A.in[I_WIN], INC, (bf16_t*)(ws + WS_WIN), r / (INC / 64), r % (INC / 64), scr, lane); continue; } r -= I_IN;
        p0_transpose_item(A.in[I_WOUT], DM, (bf16_t*)(ws + WS_WOUT), r / 32, r % 32, scr, lane);
    }
    const float* x = A.in[I_X]; const float* g1 = A.in[I_G1]; bf16_t* XN = (bf16_t*)(ws + WS_XN);
    for (int m = gw; m < NTOK; m += NGW) {
        const f32x4* xr = (const f32x4*)(x + (size_t)m * DM) + lane;
        f32x4 v[8]; float s = 0.f;
#pragma unroll
        for (int j = 0; j < 8; ++j) { v[j] = xr[64 * j]; s += (v[j].x * v[j].x + v[j].y * v[j].y) + (v[j].z * v[j].z + v[j].w * v[j].w); }
        const float rstd = 1.0f / sqrtf(wave_sum(s) * (1.f / DM) + NORM_EPS);
        u32x2* o8 = (u32x2*)(XN + (size_t)m * DM) + lane;
#pragma unroll
        for (int j = 0; j < 8; ++j) { const f32x4 g = ((const f32x4*)g1)[lane + 64 * j]; const f32x4 y = v[j] * rstd * g; o8[64 * j] = (u32x2){cvt_pk_bf16(y.x, y.y), cvt_pk_bf16(y.z, y.w)}; }
    }
    const int* pos = (const int*)A.in[I_POS]; float* CS = (float*)(ws + WS_COS); float* SN = (float*)(ws + WS_SIN);
    for (int idx = (vcu * 512 + (int)threadIdx.x); idx < NTOK * 128; idx += G * 512) {
        const int m = idx >> 7, i = idx & 127;
        const float pw = (float)exp2((double)i * (13.287712379549449 / 128.0));
        const float invf = 1.0f / pw;
        const float ang = (float)pos[m] * invf;
        float c, s; sincos_d((double)ang, c, s);
        CS[idx] = c; SN[idx] = s;
    }
    { const float* g2 = A.in[I_G2]; const float* RW = A.in[I_RW]; bf16_t* RWT = (bf16_t*)(ws + WS_RT + RT_RWT);
      for (int idx = (vcu * 512 + (int)threadIdx.x); idx < 32 * 2048; idx += G * 512) {
          const int j = idx >> 11, k = idx & 2047;
          const float v = g2[k] * RW[(size_t)k * 32 + j];
          const unsigned hi = cvt_pk_bf16(v, 0.f) & 0xffffu; const float lo = v - bf_lo(hi);
          RWT[idx] = (bf16_t)hi; RWT[32 * 2048 + idx] = (bf16_t)(cvt_pk_bf16(lo, 0.f) & 0xffffu);
      } }
}

constexpr int CONV_GU_ITEMS = 64 * 256, CONV_D_ITEMS = 32 * 256, CONV_CLAIM = 8, CONV_RESERVE = 1024;
template <bool DOWN>
__device__ __forceinline__ void conv_drain(const Args& A, LAS unsigned char* lds, int wave, int lane, unsigned* qctr, const int base, const int count) {
    unsigned char* ws = A.ws;
    volatile LAS unsigned* cq = (volatile LAS unsigned*)(lds + CTL_OFF + 128);
    LAS unsigned* scr = (LAS unsigned*)(lds + wave * 17408);
    constexpr int NIT = DOWN ? CONV_D_ITEMS : CONV_GU_ITEMS;
    for (;;) {
        if (threadIdx.x == 0) cq[0] = __hip_atomic_fetch_add(qctr, (unsigned)CONV_CLAIM, RLX_AGENT);
        __syncthreads();
        const unsigned start = cq[0];
        __syncthreads();
        if (start >= (unsigned)count) break;
#pragma unroll 1
        for (int j = 0; j < CONV_CLAIM / 8; ++j) {
            const int r = base + (int)start + j * 8 + wave;
            if (r < base + count) {
                const int mat = r >> 8, rr = r & 255, e = DOWN ? mat : (mat >> 1);
                const float* src = (DOWN ? A.in[I_WD] : (mat & 1) ? A.in[I_WU] : A.in[I_WG]) + (size_t)e * 2048 * 2048;
                unsigned char* dst = ws + (DOWN ? WS_WD : (mat & 1) ? WS_WU : WS_WG) + (size_t)e * 2048 * 2048;
                p0_transpose_item_fp8(src, dst, rr >> 5, rr & 31, scr, lane);
            }
        }
    }
}

__device__ __forceinline__ void glds16_asm(const void* gsrc, unsigned lds_dst) {
    unsigned keep;
    asm volatile("s_mov_b32 %0, m0\n\ts_mov_b32 m0, %2\n\ts_nop 0\n\tglobal_load_lds_dwordx4 %1, off\n\ts_mov_b32 m0, %0" : "=&s"(keep) : "v"(gsrc), "s"(lds_dst) : "memory");
}
template <int D> struct BandCfg { static constexpr int ROWB = D * 2, TILEB = 64 * ROWB, STAGEB = 2 * TILEB, NS = D / 32, NDT = D / 16, NPW = (TILEB / 1024) / 8  , RPI = 1024 / ROWB  ; };

__device__ constexpr double kLog2Gamma[4] = { -0.04580368961312479, -0.018003552928331026, -0.007117849617096985, -0.0028205190623786626 };

template <int D, bool ATT>
__device__ __forceinline__ void band_unit(const Args& A, LAS unsigned char* lds, int b, int h, int cp, int wave, int lane) {
    typedef BandCfg<D> C;
    const bf16_t* PROJ = (const bf16_t*)(A.ws + WS_PROJ);
    bf16_t* MIX = (bf16_t*)(A.ws + WS_MIX);
    const int tid = threadIdx.x, qt = wave & 3, qc = wave >> 2, g4 = lane >> 4, li = lane & 15;
    const int qoff = ATT ? OFF_AQ + h * 128 : OFF_RQ + h * 256, koff = ATT ? OFF_AK + h * 128 : OFF_RK + h * 256, voff = ATT ? OFF_AV + h * 128 : OFF_RV + h * 256;
    const int cq = 2 * cp + qc;
    const int qrow = b * SEQ + cq * CH + 16 * qt + li, nq = 16 * qt + li;
    LAS float* btab = (LAS float*)(lds + TAB_OFF + 1024);
    if (ATT) { if (tid < 320) btab[tid] = A.in[I_RELB][h * 320 + tid] * 1.4426950408889634f; }
    unsigned srcK[C::NPW], srcV[C::NPW];
#pragma unroll
    for (int i = 0; i < C::NPW; ++i) {
        const int j = C::NPW * wave + i, row = C::RPI * j + lane / (C::ROWB / 16), pc = lane % (C::ROWB / 16);
        const int ck = (pc & 16) | ((pc ^ row) & 15), cv = (pc & 16) | ((pc ^ (2 * (row & 7))) & 15);
        srcK[i] = (unsigned)(row * (INC * 2) + koff * 2 + 16 * ck); srcV[i] = (unsigned)(row * (INC * 2) + voff * 2 + 16 * cv);
    }
#define BAND_DMA(kc_, st_) do { const char* gb_ = (const char*)PROJ + ((size_t)b * SEQ + (size_t)(kc_) * CH) * (size_t)(INC * 2); \
        const unsigned sb_ = __builtin_amdgcn_readfirstlane(lds_addr(lds + (st_) * C::STAGEB + C::NPW * wave * 1024)); \
        _Pragma("unroll") for (int i = 0; i < C::NPW; ++i) { glds16_asm(gb_ + srcK[i], sb_ + i * 1024); glds16_asm(gb_ + srcV[i], sb_ + C::TILEB + i * 1024); } } while (0)
    const int kc_hi = 2 * cp + 1, kc_lo = ATT ? (2 * cp > 8 ? 2 * cp - 8 : 0) : 0;
    BAND_DMA(kc_lo, 0);
    bf16x8 Qf[C::NS];
#pragma unroll
    for (int s = 0; s < C::NS; ++s) Qf[s] = *(const bf16x8*)(PROJ + (size_t)qrow * INC + qoff + 32 * s + 8 * g4);
#pragma unroll
    for (int s = 0; s < C::NS; ++s) asm volatile("" : "+v"(Qf[s]));
    f32x4 O[C::NDT];
#pragma unroll
    for (int d = 0; d < C::NDT; ++d) O[d] = (f32x4){0.f, 0.f, 0.f, 0.f};
    float mrun = -1e30f, lsum = 0.f;
    const float l2g = ATT ? 0.f : (float)kLog2Gamma[h];
    const int kbase = li * C::ROWB, kx = li;
    const int vr0 = 4 * g4 + (li >> 2), vbase = vr0 * C::ROWB + 8 * (li & 1), vx = 2 * (vr0 & 7), vp = (li & 3) >> 1;
    int st = 0;
    for (int kc = kc_lo; kc <= kc_hi; ++kc, st ^= 1) {
        asm volatile("s_waitcnt vmcnt(0)" ::: "memory");
        __builtin_amdgcn_s_barrier();
        asm volatile("" ::: "memory");
        if (kc < kc_hi) BAND_DMA(kc + 1, st ^ 1);
        const bool active = (kc <= cq) && (!ATT || kc >= cq - 8);
        if (active) {
        LAS unsigned char* KS = lds + st * C::STAGEB; LAS unsigned char* VS = KS + C::TILEB;
        f32x4 S[4];
#pragma unroll
        for (int t = 0; t < 4; ++t) S[t] = (f32x4){0.f, 0.f, 0.f, 0.f};
#define SCHED __builtin_amdgcn_sched_barrier(0)
#define LDK(dst, s_) do { const int ch_ = ((4 * (s_)) & 16) | (((4 * (s_) + g4) ^ kx) & 15); _Pragma("unroll") for (int t = 0; t < 4; ++t) dst[t] = *(const LAS bf16x8*)(KS + kbase + 16 * t * C::ROWB + 16 * ch_); } while (0)
        {
            bf16x8 kA[4], kB[4];
            LDK(kA, 0);
#pragma unroll
            for (int s = 0; s < C::NS; s += 2) {
                LDK(kB, s + 1); SCHED;
#pragma unroll
                for (int t = 0; t < 4; ++t) S[t] = __builtin_amdgcn_mfma_f32_16x16x32_bf16(kA[t], Qf[s], S[t], 0, 0, 0);
                SCHED;
                if (s + 2 < C::NS) LDK(kA, s + 2);
                SCHED;
#pragma unroll
                for (int t = 0; t < 4; ++t) S[t] = __builtin_amdgcn_mfma_f32_16x16x32_bf16(kB[t], Qf[s + 1], S[t], 0, 0, 0);
                SCHED;
            }
        }
#undef LDK
        const int rel0 = 64 * (cq - kc) + nq - 4 * g4;
        float p[16];
        if (ATT) {
            float sc[16];
#pragma unroll
            for (int t = 0; t < 4; ++t)
#pragma unroll
                for (int r = 0; r < 4; ++r) { int i0 = rel0 - 16 * t - r; i0 = (i0 > 256 ? 256 : i0) + 63; sc[4 * t + r] = S[t][r] * (0.08838834764831845f * 1.4426950408889634f) + btab[i0]; }
            float mx = sc[0];
#pragma unroll
            for (int r = 1; r < 16; ++r) mx = fmaxf(mx, sc[r]);
            mx = fmaxf(mx, __shfl_xor(mx, 16)); mx = fmaxf(mx, __shfl_xor(mx, 32));
            const float mnew = fmaxf(mrun, mx), alpha = __builtin_amdgcn_exp2f(mrun - mnew);
            float ps = 0.f;
#pragma unroll
            for (int r = 0; r < 16; ++r) { p[r] = __builtin_amdgcn_exp2f(sc[r] - mnew); ps += p[r]; }
            lsum = lsum * alpha + ps; mrun = mnew;
#pragma unroll
            for (int d = 0; d < C::NDT; ++d) O[d] = O[d] * alpha;
        } else {
#pragma unroll
            for (int t = 0; t < 4; ++t)
#pragma unroll
                for (int r = 0; r < 4; ++r) { int d0 = rel0 - 16 * t - r; d0 = d0 < 0 ? -d0 : d0; p[4 * t + r] = S[t][r] * __builtin_amdgcn_exp2f(l2g * (float)d0); }
        }
        bf16x8 Pf[2];
#pragma unroll
        for (int ks = 0; ks < 2; ++ks) { const u32x4 pk = (u32x4){cvt_pk_bf16(p[8 * ks], p[8 * ks + 1]), cvt_pk_bf16(p[8 * ks + 2], p[8 * ks + 3]), cvt_pk_bf16(p[8 * ks + 4], p[8 * ks + 5]), cvt_pk_bf16(p[8 * ks + 6], p[8 * ks + 7])}; Pf[ks] = __builtin_bit_cast(bf16x8, pk); }
#define LDV(dst, i_) do { _Pragma("unroll") for (int dd = 0; dd < 2; ++dd) { const int d_ = 2 * (i_) + dd; const int ch_ = ((2 * d_) & 16) | (((2 * d_ + vp) ^ vx) & 15); \
            _Pragma("unroll") for (int ks = 0; ks < 2; ++ks) { \
                const s16x4 lo_ = __builtin_amdgcn_ds_read_tr16_b64_v4i16((LAS s16x4*)(VS + vbase + 32 * ks * C::ROWB + 16 * ch_)); \
                const s16x4 hi_ = __builtin_amdgcn_ds_read_tr16_b64_v4i16((LAS s16x4*)(VS + vbase + (32 * ks + 16) * C::ROWB + 16 * ch_)); \
                dst[2 * dd + ks] = __builtin_shufflevector(lo_, hi_, 0, 1, 2, 3, 4, 5, 6, 7); } } } while (0)
#define PVMMA(src, i_) do { _Pragma("unroll") for (int dd = 0; dd < 2; ++dd) { O[2 * (i_) + dd] = __builtin_amdgcn_mfma_f32_16x16x32_bf16(src[2 * dd], Pf[0], O[2 * (i_) + dd], 0, 0, 0); \
            O[2 * (i_) + dd] = __builtin_amdgcn_mfma_f32_16x16x32_bf16(src[2 * dd + 1], Pf[1], O[2 * (i_) + dd], 0, 0, 0); } } while (0)
        {
            bf16x8 vA[4], vB[4];
            SCHED; LDV(vA, 0);
#pragma unroll
            for (int i = 0; i < C::NDT / 2; i += 2) {
                LDV(vB, i + 1); SCHED;
                PVMMA(vA, i); SCHED;
                if (i + 2 < C::NDT / 2) LDV(vA, i + 2);
                SCHED;
                PVMMA(vB, i + 1); SCHED;
            }
        }
#undef LDV
#undef PVMMA
#undef SCHED
        }
    }
    if (ATT) {
        lsum += __shfl_xor(lsum, 16); lsum += __shfl_xor(lsum, 32);
        const float linv = __builtin_amdgcn_rcpf(lsum);
        bf16_t* op = MIX + (size_t)qrow * DM + 1024 + h * 128 + 4 * g4;
#pragma unroll
        for (int d = 0; d < C::NDT; ++d) *(u32x2*)(op + 16 * d) = (u32x2){cvt_pk_bf16(O[d].x * linv, O[d].y * linv), cvt_pk_bf16(O[d].z * linv, O[d].w * linv)};
    } else {
        float ss = 0.f;
#pragma unroll
        for (int d = 0; d < C::NDT; ++d) ss += (O[d].x * O[d].x + O[d].y * O[d].y) + (O[d].z * O[d].z + O[d].w * O[d].w);
        ss += __shfl_xor(ss, 16); ss += __shfl_xor(ss, 32);
        const float rinv = 1.0f / sqrtf(ss * (1.f / 256.f) + NORM_EPS);
        const bf16_t* gp = PROJ + (size_t)qrow * INC + OFF_RG + h * 256 + 4 * g4;
        bf16_t* op = MIX + (size_t)qrow * DM + h * 256 + 4 * g4;
#pragma unroll
        for (int d = 0; d < C::NDT; ++d) {
            const u32x2 gv = *(const u32x2*)(gp + 16 * d);
            const float ga = bf_lo(gv.x), gb = bf_hi(gv.x), gc = bf_lo(gv.y), gd = bf_hi(gv.y);
            const float ya = O[d].x * rinv * (ga * __builtin_amdgcn_rcpf(1.0f + __expf(-ga))), yb = O[d].y * rinv * (gb * __builtin_amdgcn_rcpf(1.0f + __expf(-gb)));
            const float yc = O[d].z * rinv * (gc * __builtin_amdgcn_rcpf(1.0f + __expf(-gc))), yd = O[d].w * rinv * (gd * __builtin_amdgcn_rcpf(1.0f + __expf(-gd)));
            *(u32x2*)(op + 16 * d) = (u32x2){cvt_pk_bf16(ya, yb), cvt_pk_bf16(yc, yd)};
        }
    }
    __syncthreads();
#undef BAND_DMA
}

__device__ __forceinline__ void p2_mixers(const Args& A, LAS unsigned char* lds, int wave, int lane, int vcu, int G) {
    for (int v = vcu; v < 256; v += G) {
        if (v < 128) { const int bh = v >> 3, p = v & 7; band_unit<256, false>(A, lds, bh >> 2, bh & 3, 15 - p, wave, lane); band_unit<256, false>(A, lds, bh >> 2, bh & 3, p, wave, lane); }
        else { const int a = v - 128, bh = a >> 2, q = a & 3;
#pragma unroll 1
            for (int i = 3; i >= 0; --i) band_unit<128, true>(A, lds, bh >> 3, bh & 7, q + 4 * i, wave, lane); }
    }
}

__device__ __forceinline__ void p2_mixers_workers(const Args& A, LAS unsigned char* lds, int wave, int lane, int wv) {
    if (wv < 128) { const int bh = wv >> 3, p = wv & 7; band_unit<256, false>(A, lds, bh >> 2, bh & 3, 15 - p, wave, lane); band_unit<256, false>(A, lds, bh >> 2, bh & 3, p, wave, lane); }
    constexpr int L0 = 8 * (NG1 - 128);
    const int a0 = wv >= 128 ? 8 * (wv - 128) : L0 + wv, na = wv >= 128 ? 8 : (L0 + wv < 512 ? 1 : 0);
#pragma unroll 1
    for (int i = na - 1; i >= 0; --i) { const int a = a0 + i, bh = a >> 4, idx = a & 15, cp = 2 * (idx & 7) + (idx >> 3); band_unit<128, true>(A, lds, bh >> 3, bh & 7, cp, wave, lane); }
}

__device__ __forceinline__ void p4_router(const Args& A, LAS unsigned char* lds, int wave, int lane, int G) {
    const bf16_t* H1 = (const bf16_t*)(A.ws + WS_H1); const float* RB = A.in[I_RB];
    unsigned char* rt = A.ws + WS_RT;
    const bf16_t* RWT = (const bf16_t*)(rt + RT_RWT);
    int* TOPE = (int*)(rt + RT_TOPE); float* TOPW = (float*)(rt + RT_TOPW); float* RSTD = (float*)(rt + RT_RSTD); int* LRANK = (int*)(rt + RT_LRANK); int* HIST = (int*)(rt + RT_HIST);
    const int tid = threadIdx.x, li = lane & 15, g4 = lane >> 4;
    LAS float* part = (LAS float*)lds;
    LAS float* ssqp = (LAS float*)(lds + 32768);
    LAS int* esel = (LAS int*)(ssqp + 256);
    LAS int* c0 = esel + 128;
    for (int blk = blockIdx.x; blk < NTOK / 32; blk += G) {
        const int tok0 = blk * 32;
        f32x4 acc[2][2];
#pragma unroll
        for (int mt = 0; mt < 2; ++mt)
#pragma unroll
            for (int nt = 0; nt < 2; ++nt) acc[mt][nt] = (f32x4){0.f, 0.f, 0.f, 0.f};
        float sq[2] = {0.f, 0.f};
#pragma unroll
        for (int hs = 0; hs < 2; ++hs) {
            bf16x8 af[2][4], bh[2][4], bl[2][4];
#pragma unroll
            for (int s = 0; s < 4; ++s) {
                const int k = 256 * wave + 32 * (4 * hs + s) + 8 * g4;
#pragma unroll
                for (int mt = 0; mt < 2; ++mt) af[mt][s] = *(const bf16x8*)(H1 + (size_t)(tok0 + 16 * mt + li) * DM + k);
#pragma unroll
                for (int nt = 0; nt < 2; ++nt) { bh[nt][s] = *(const bf16x8*)(RWT + (size_t)(16 * nt + li) * 2048 + k); bl[nt][s] = *(const bf16x8*)(RWT + 32 * 2048 + (size_t)(16 * nt + li) * 2048 + k); }
            }
#pragma unroll
            for (int s = 0; s < 4; ++s)
#pragma unroll
                for (int mt = 0; mt < 2; ++mt) {
                    const u32x4 au = __builtin_bit_cast(u32x4, af[mt][s]);
#pragma unroll
                    for (int e = 0; e < 4; ++e) { const float x0 = bf_lo(au[e]), x1 = bf_hi(au[e]); sq[mt] += x0 * x0 + x1 * x1; }
#pragma unroll
                    for (int nt = 0; nt < 2; ++nt) {
                        acc[mt][nt] = __builtin_amdgcn_mfma_f32_16x16x32_bf16(af[mt][s], bh[nt][s], acc[mt][nt], 0, 0, 0);
                        acc[mt][nt] = __builtin_amdgcn_mfma_f32_16x16x32_bf16(af[mt][s], bl[nt][s], acc[mt][nt], 0, 0, 0);
                    }
                }
        }
#pragma unroll
        for (int mt = 0; mt < 2; ++mt) {
            float q = sq[mt]; q += __shfl_xor(q, 16); q += __shfl_xor(q, 32);
            if (g4 == 0) ssqp[wave * 32 + 16 * mt + li] = q;
#pragma unroll
            for (int nt = 0; nt < 2; ++nt)
#pragma unroll
                for (int r = 0; r < 4; ++r) part[(wave * 32 + 16 * mt + 4 * g4 + r) * 32 + 16 * nt + li] = acc[mt][nt][r];
        }
        __syncthreads();
#pragma unroll
        for (int pp = 0; pp < 2; ++pp) {
            const int p = tid + 512 * pp, tok = p >> 5, j = p & 31; float s = 0.f, q = 0.f;
#pragma unroll
            for (int w = 0; w < 8; ++w) { s += part[(w * 32 + tok) * 32 + j]; q += ssqp[w * 32 + tok]; }
            const float rstd = 1.0f / sqrtf(q * (1.f / DM) + NORM_EPS);
            float v = s * rstd + RB[j];
            float lv[4]; int le[4];
#pragma unroll
            for (int k = 0; k < 4; ++k) {
                float bv = v; int bi = j;
#pragma unroll
                for (int off = 16; off >= 1; off >>= 1) { const float ov = __shfl_xor(bv, off); const int oi = __shfl_xor(bi, off); const bool take = (ov > bv) || (ov == bv && oi < bi); bv = take ? ov : bv; bi = take ? oi : bi; }
                lv[k] = bv; le[k] = bi; v = (j == bi) ? -3.0e38f : v;
            }
            if (j == 0) {
                const float e1 = __expf(lv[1] - lv[0]), e2 = __expf(lv[2] - lv[0]), e3 = __expf(lv[3] - lv[0]); const float inv = 1.0f / (1.0f + e1 + e2 + e3);
                RSTD[tok0 + tok] = rstd;
                *(i32x4*)(TOPE + (size_t)(tok0 + tok) * 4) = (i32x4){le[0], le[1], le[2], le[3]};
                *(f32x4*)(TOPW + (size_t)(tok0 + tok) * 4) = (f32x4){inv, e1 * inv, e2 * inv, e3 * inv};
                *(LAS i32x4*)(esel + tok * 4) = (i32x4){le[0], le[1], le[2], le[3]};
            }
        }
        __syncthreads();
        int myrank = 0, mycnt = 0, mye = -1;
        if (wave < 2) {
            mye = esel[64 * wave + lane];
            for (int j = 0; j < 32; ++j) {
                const unsigned long long m = __ballot(mye == j);
                if (mye == j) myrank = __popcll(m & ((1ull << lane) - 1ull));
                if (lane == j) mycnt = __popcll(m);
            }
            if (wave == 0 && lane < 32) c0[lane] = mycnt;
        }
        __syncthreads();
        if (wave < 2) {
            if (wave == 1) myrank += c0[mye];
            LRANK[tok0 * 4 + 64 * wave + lane] = myrank;
            if (wave == 1 && lane < 32) HIST[blk * 32 + lane] = c0[lane] + mycnt;
        }
        __syncthreads();
    }
}

__device__ __forceinline__ void p5_scatter(const Args& A, LAS unsigned char* lds, int wave, int lane, int G) {
    const bf16_t* H1 = (const bf16_t*)(A.ws + WS_H1); const float* g2 = A.in[I_G2];
    unsigned char* rt = A.ws + WS_RT; unsigned* ctl = (unsigned*)(A.ws + WS_CTL);
    const int* TOPE = (const int*)(rt + RT_TOPE); const float* TOPW = (const float*)(rt + RT_TOPW); const float* RSTD = (const float*)(rt + RT_RSTD); const int* LRANK = (const int*)(rt + RT_LRANK); const int* HIST = (const int*)(rt + RT_HIST);
    int* TOKPOS = (int*)(rt + RT_TOKPOS); float* SLOTW = (float*)(rt + RT_SLOTW);
    unsigned char* XG = A.ws + WS_XG;
    int* SRC = (int*)(rt + RT_SRC);
    const int tid = threadIdx.x;
    LAS int* psum = (LAS int*)lds; LAS int* pin = psum + 512; LAS int* cnt = pin + 512; LAS int* pad = cnt + 32; LAS int* pst = pad + 32; LAS int* basee = pst + 32;
    f32x4 g2v[2][4];
#pragma unroll
    for (int h = 0; h < 2; ++h)
#pragma unroll
        for (int q = 0; q < 4; ++q) g2v[h][q] = ((const f32x4*)g2)[4 * (lane + 64 * h) + q];
    for (int blk = blockIdx.x; blk < NTOK / 32; blk += G) {
        const int tok0 = blk * 32;
        { const int e = tid & 31, pt = tid >> 5; int s = 0, inp = 0;
            for (int bb = 0; bb < 16; ++bb) { const int b2 = pt * 16 + bb; const int c = HIST[b2 * 32 + e]; s += c; inp += (b2 < blk) ? c : 0; }
            psum[pt * 32 + e] = s; pin[pt * 32 + e] = inp; }
        __syncthreads();
        if (tid < 32) { int tot = 0, bs = 0; for (int pt = 0; pt < 16; ++pt) { tot += psum[pt * 32 + tid]; bs += pin[pt * 32 + tid]; } cnt[tid] = tot; pad[tid] = (tot + 255) & ~255; basee[tid] = bs; }
        __syncthreads();
        if (tid < 32) { int ps = 0; for (int e = 0; e < tid; ++e) ps += pad[e]; pst[tid] = ps; basee[tid] += ps; }
        __syncthreads();
        if (blk == 0 && tid == 0) { int mt = 0; for (int e = 0; e < 32; ++e) { const int n = pad[e] >> 8; for (int i = 0; i < n; ++i) { __hip_atomic_store(ctl + CW_MTE + mt, (unsigned)e, RLX_AGENT); ++mt; } } __hip_atomic_store(ctl + CW_NMT, (unsigned)mt, RLX_AGENT); }
        int pos = 0;
        if (lane < 16) { const int a = (tok0 + 4 * wave) * 4 + lane; const int e = TOPE[a]; pos = basee[e] + LRANK[a]; TOKPOS[a] = pos; SLOTW[pos] = TOPW[a]; SRC[pos] = tok0 + 4 * wave + (lane >> 2); }
        float rstd4 = 0.f; if (lane < 4) rstd4 = RSTD[tok0 + 4 * wave + lane];
        u32x4 hv[4][2][2];
#pragma unroll
        for (int i = 0; i < 4; ++i)
#pragma unroll
            for (int h = 0; h < 2; ++h) { const u32x4* xr = (const u32x4*)(H1 + (size_t)(tok0 + 4 * wave + i) * DM + 16 * (lane + 64 * h)); hv[i][h][0] = xr[0]; hv[i][h][1] = xr[1]; }
#pragma unroll
        for (int i = 0; i < 4; ++i) {
            const float rstd = __shfl(rstd4, i);
#pragma unroll
            for (int h = 0; h < 2; ++h) {
                unsigned o[4];
#pragma unroll
                for (int q = 0; q < 4; ++q) {
                    const unsigned w0 = hv[i][h][q >> 1][2 * (q & 1)], w1 = hv[i][h][q >> 1][2 * (q & 1) + 1];
                    const f32x4 g = g2v[h][q];
                    o[q] = cvt_pk4_fp8(bf_lo(w0) * rstd * g.x, bf_hi(w0) * rstd * g.y, bf_lo(w1) * rstd * g.z, bf_hi(w1) * rstd * g.w);
                }
                const u32x4 ov = (u32x4){o[0], o[1], o[2], o[3]};
                const size_t co = (size_t)16 * (lane + 64 * h);
                *(u32x4*)(XG + (size_t)(tok0 + 4 * wave + i) * DM + co) = ov;
            }
        }
        {
            const int e = blk & 31, part = blk >> 5;
            const int r0 = pst[e] + cnt[e], r1 = pst[e] + pad[e];
            for (int r = r0 + part * 512 + (int)threadIdx.x; r < r1; r += 4096) { SRC[r] = NTOK; SLOTW[r] = 0.f; }
            if (blk == 0 && threadIdx.x < 128) ((u32x4*)(XG + (size_t)NTOK * DM))[threadIdx.x] = (u32x4){0u, 0u, 0u, 0u};
        }
        __syncthreads();
    }
}

typedef float f32x2 __attribute__((ext_vector_type(2)));
__device__ __forceinline__ f32x4 fp8x4_to_f32(unsigned u) { const f32x2 lo = __builtin_amdgcn_cvt_pk_f32_fp8((int)u, false), hi = __builtin_amdgcn_cvt_pk_f32_fp8((int)u, true); return (f32x4){lo.x, lo.y, hi.x, hi.y}; }
__device__ __forceinline__ void p8_final(const Args& A, int wave, int lane, int vcu, int G) {
    const bf16_t* H1 = (const bf16_t*)(A.ws + WS_H1); const float* gf = A.in[I_GF]; const unsigned char* YB = A.ws + WS_YB;
    const int* TOKPOS = (const int*)(A.ws + WS_RT + RT_TOKPOS);
    const int gw = vcu * 8 + wave, NGW = G * 8;
    for (int tok0 = gw; tok0 < NTOK; tok0 += 4 * NGW) {
        int pos = 0; { const int t = tok0 + (lane >> 2) * NGW; if (lane < 16 && t < NTOK) pos = TOKPOS[t * 4 + (lane & 3)]; }
        unsigned yr[2][4][8]; u32x2 hr[2][8];
#define P8_LOAD(i_, bf_) do { const int t_ = tok0 + (i_) * NGW; if (t_ < NTOK) { \
            const u32x2* xr_ = (const u32x2*)(H1 + (size_t)t_ * DM) + lane; \
            _Pragma("unroll") for (int k = 0; k < 4; ++k) { const unsigned* y_ = (const unsigned*)(YB + (size_t)__shfl(pos, 4 * (i_) + k) * DM) + lane; \
                _Pragma("unroll") for (int j = 0; j < 8; ++j) yr[bf_][k][j] = __builtin_nontemporal_load(y_ + 64 * j); } \
            _Pragma("unroll") for (int j = 0; j < 8; ++j) hr[bf_][j] = __builtin_nontemporal_load(xr_ + 64 * j); } } while (0)
        P8_LOAD(0, 0);
#pragma unroll
        for (int i = 0; i < 4; ++i) {
            const int tok = tok0 + i * NGW;
            if (i + 1 < 4) P8_LOAD(i + 1, (i + 1) & 1);
            if (tok < NTOK) {
                f32x4 v[8]; float s = 0.f;
#pragma unroll
                for (int j = 0; j < 8; ++j) {
                    const f32x4 y = (fp8x4_to_f32(yr[i & 1][0][j]) + fp8x4_to_f32(yr[i & 1][1][j])) + (fp8x4_to_f32(yr[i & 1][2][j]) + fp8x4_to_f32(yr[i & 1][3][j]));
                    const u32x2 hb = hr[i & 1][j];
                    v[j] = (f32x4){bf_lo(hb.x), bf_hi(hb.x), bf_lo(hb.y), bf_hi(hb.y)} + y * 0.0625f;
                    s += (v[j].x * v[j].x + v[j].y * v[j].y) + (v[j].z * v[j].z + v[j].w * v[j].w);
                }
                const float rstd = 1.0f / sqrtf(wave_sum(s) * (1.f / DM) + NORM_EPS);
                f32x4* o = (f32x4*)(A.out + (size_t)tok * DM) + lane;
#pragma unroll
                for (int j = 0; j < 8; ++j) __builtin_nontemporal_store(v[j] * rstd * ((const f32x4*)gf)[lane + 64 * j], o + 64 * j);
            }
        }
#undef P8_LOAD
    }
}

__global__ void __launch_bounds__(512, 2) hybrid_fwd(Args args) {
    extern __shared__ __attribute__((aligned(16))) unsigned char lds_raw[];
    LAS unsigned char* lds = (LAS unsigned char*)lds_raw;
    const int tid = threadIdx.x, lane = tid & 63, wave = __builtin_amdgcn_readfirstlane(tid >> 6);
    const int G = gridDim.x; const int bx = blockIdx.x; const int vcu = (G % 8 == 0) ? (bx % 8) * (G / 8) + bx / 8 : bx;
    unsigned char* ws = args.ws;
    unsigned* ctl = (unsigned*)(ws + WS_CTL);
    for (int u = tid; u < 256; u += 512) ((LAS unsigned*)(lds + CTL_OFF))[u] = 0u;
    __syncthreads();
    const int lo = args.ph_lo, hi = args.ph_hi;
    XcdBarrier bar = xcd_barrier_post(ctl + CW_BAR, (volatile LAS unsigned*)(lds + CTL_OFF), (unsigned)G);
#ifndef PHASE_MASK
#define PHASE_MASK 0x1ff
#endif
#define IN(k) (((PHASE_MASK >> (k)) & 1) && lo <= (k) && (k) < hi)
#ifdef PROBE_PHASE
    unsigned long long pr_t0 = 0, pr_t1 = 0;
#ifndef PROBE_PHASE_HI
#define PROBE_PHASE_HI PROBE_PHASE
#endif
#define PROBE_AT(k, which) do { if (which == 0 && (k) == PROBE_PHASE) pr_t0 = __builtin_amdgcn_s_memrealtime(); if (which == 1 && (k) == PROBE_PHASE_HI) pr_t1 = __builtin_amdgcn_s_memrealtime(); } while (0)
#else
#define PROBE_AT(k, which) do { } while (0)
#endif
#define SEAM(k) do { if (IN(k) && IN((k) + 1)) xcd_barrier(bar); PROBE_AT(k, 1); PROBE_AT((k) + 1, 0); } while (0)
    PROBE_AT(0, 0);

    if (G > NG1) {
        if (bx < NG1) {
            XcdBarrier barW = xcd_barrier_post(ctl + CW_BARW, (volatile LAS unsigned*)(lds + CTL_OFF + 16), (unsigned)NG1);
            const int wv = (NG1 % 8 == 0) ? (bx % 8) * (NG1 / 8) + bx / 8 : bx;
            p0_prologue(args, lds, wave, lane, bx, NG1);
            xcd_barrier(barW);
            {
                DenseOrder S; S.init(ws + WS_XN, ws + WS_WIN, NTOK, INC, NG1, bx);
                EpiInProj E{(bf16_t*)(ws + WS_PROJ), (const float*)(ws + WS_COS), (const float*)(ws + WS_SIN)};
                gemm_phase<EpiInProj, DenseOrder, false>(lds + RING_OFF, S, E, (size_t)HALF * KD * 2);
            }
            xcd_barrier(barW);
            p2_mixers_workers(args, lds, wave, lane, wv);
        }
        conv_drain<false>(args, lds, wave, lane, ctl + CW_CQ, 0, CONV_GU_ITEMS);
    } else {
        p0_prologue(args, lds, wave, lane, vcu, G);
        xcd_barrier(bar);
        {
            DenseOrder S; S.init(ws + WS_XN, ws + WS_WIN, NTOK, INC, G, bx);
            EpiInProj E{(bf16_t*)(ws + WS_PROJ), (const float*)(ws + WS_COS), (const float*)(ws + WS_SIN)};
            gemm_phase<EpiInProj, DenseOrder, false>(lds + RING_OFF, S, E, (size_t)HALF * KD * 2);
        }
        conv_drain<false>(args, lds, wave, lane, ctl + CW_CQ, 0, CONV_GU_ITEMS);
        xcd_barrier(bar);
        p2_mixers(args, lds, wave, lane, vcu, G);
    }
    xcd_barrier(bar);
    PROBE_AT(2, 1); PROBE_AT(3, 0);
    if (IN(3)) {
        DenseOrder S; S.init(ws + WS_MIX, ws + WS_WOUT, NTOK, DM, G, bx);
        EpiOutProj E{args.in[I_X], (bf16_t*)(ws + WS_H1)};
        gemm_phase<EpiOutProj, DenseOrder, false>(lds + RING_OFF, S, E, (size_t)HALF * KD * 2);
    }
    SEAM(3);
    if (IN(4)) { p4_router(args, lds, wave, lane, G); }
    SEAM(4);
    if (IN(5)) { p5_scatter(args, lds, wave, lane, G); }
    SEAM(5);
    if (IN(6) || IN(7)) {
        LAS int* mte = (LAS int*)(lds + TAB_OFF);
        if (tid < MAXMT) mte[tid] = (int)ld_u32_agent(ctl + CW_MTE + tid);
        if (tid == 0) mte[MAXMT] = (int)ld_u32_agent(ctl + CW_NMT);
        __syncthreads();
        if (tid < 32) { const int n = mte[MAXMT]; int first = -1, cntt = 0; for (int m = 0; m < n; ++m) if (mte[m] == tid) { if (first < 0) first = m; ++cntt; } mte[MOE_EST + tid] = first < 0 ? 0 : first; mte[MOE_ECN + tid] = cntt; }
        __syncthreads();
    }
    if (IN(6)) {
        if (bx < NG6 || G <= NG6) {
            const LAS int* mte = (const LAS int*)(lds + TAB_OFF);
            MoeOrder<16, 128, true> S; S.A = (const char*)(ws + WS_XG); S.B = (const char*)(ws + WS_WG); S.mte = mte; S.nmt = __builtin_amdgcn_readfirstlane(mte[MAXMT]); S.G = G <= NG6 ? G : NG6; S.c = bx;
            S.src = (const int*)(ws + WS_RT + RT_SRC);
            EpiGateUp E{ws + WS_HID, args.in[I_BG], args.in[I_BU]};
            gemm_phase<EpiGateUp, MoeOrder<16, 128, true>, true>(lds + RING_OFF, S, E, (size_t)(WS_WU - WS_WG));
        }
        conv_drain<true>(args, lds, wave, lane, ctl + CW_CQD, 0, CONV_D_ITEMS);
    }
    SEAM(6);
    if (IN(7)) {
        const LAS int* mte = (const LAS int*)(lds + TAB_OFF);
        MoeOrder<8, 256> S; S.A = (const char*)(ws + WS_HID); S.B = (const char*)(ws + WS_WD); S.mte = mte; S.nmt = __builtin_amdgcn_readfirstlane(mte[MAXMT]); S.G = G; S.c = bx;
        EpiDown E{ws + WS_YB, args.in[I_BD], (const float*)(ws + WS_RT + RT_SLOTW)};
        gemm_phase<EpiDown, MoeOrder<8, 256>, true>(lds + RING_OFF, S, E, (size_t)HALF * KD);
    }
    SEAM(7);
    if (IN(8)) { p8_final(args, wave, lane, vcu, G); }
#ifdef PROBE_PHASE
    PROBE_AT(8, 1);
    if (bx == 0) { const unsigned long long t2 = __builtin_amdgcn_s_memrealtime(), dt = (pr_t1 - pr_t0) * PROBE_MULT; while (__builtin_amdgcn_s_memrealtime() - t2 < dt) __builtin_amdgcn_s_sleep(16); }
#endif
#undef IN
#undef SEAM
}
}

#ifndef N_LAUNCHES
#define N_LAUNCHES 1
#endif

extern "C" void kernel_launch(void* const* d_in, const int* in_sizes, int n_in, void* d_out, int out_size, void* d_ws, size_t ws_size, hipStream_t stream) {
    static int grid = 0;
    if (grid == 0) {
        if (n_in != 16 || out_size != NTOK * DM || ws_size < WS_END) { fprintf(stderr, "kernel_launch: unexpected shapes (n_in %d out %d ws %zu)\n", n_in, out_size, ws_size); grid = -1; return; }
        int dev = 0, cus = 0, per_cu = 0;
        if (hipGetDevice(&dev) != hipSuccess || hipDeviceGetAttribute(&cus, hipDeviceAttributeMultiprocessorCount, dev) != hipSuccess) { grid = -1; return; }
        if (hipFuncSetAttribute((const void*)hybrid_fwd, hipFuncAttributeMaxDynamicSharedMemorySize, LDS_BYTES) != hipSuccess) { fprintf(stderr, "kernel_launch: hipFuncSetAttribute failed\n"); grid = -1; return; }
        if (hipOccupancyMaxActiveBlocksPerMultiprocessor(&per_cu, (const void*)hybrid_fwd, 512, LDS_BYTES) != hipSuccess || per_cu < 1) { fprintf(stderr, "kernel_launch: occupancy query says %d\n", per_cu); (void)hipGetLastError(); per_cu = 1; }
        grid = cus;
    }
    if (grid < 0) return;
    (void)in_sizes;
    if (hipMemsetAsync((char*)d_ws + WS_CTL, 0, CTL_ZERO_BYTES, stream) != hipSuccess) { fprintf(stderr, "kernel_launch: memset failed\n"); return; }
    Args a{};
    for (int i = 0; i < 16; ++i) a.in[i] = (const float*)d_in[i];
    a.out = (float*)d_out; a.ws = (unsigned char*)d_ws;
#if N_LAUNCHES == 1
    a.ph_lo = 0; a.ph_hi = NPHASE;
    hipLaunchKernelGGL(hybrid_fwd, dim3(grid), dim3(512), LDS_BYTES, stream, a);
#else
    for (int p = 0; p < NPHASE; ++p) { a.ph_lo = p; a.ph_hi = p + 1; hipLaunchKernelGGL(hybrid_fwd, dim3(grid), dim3(512), LDS_BYTES, stream, a); }
#endif
    const hipError_t le = hipPeekAtLastError();
    if (le != hipSuccess) fprintf(stderr, "kernel_launch: launch failed: %s\n", hipGetErrorName(le));
}
```
